# Optimizing an MI355X kernel written in HIP

```python
import math
import jax
import jax.numpy as jnp
from jax import lax
import numpy as np

D_MODEL = 1024
BATCH = 32
SEQ = 2048
DEPTH = 2

GRID_W = 64
CTX_LEN = 256
N_EVEN = (DEPTH + 1) // 2
N_ODD = DEPTH // 2
ADA_CHUNKS = 6
NORM_EPS = 1e-6
ROPE_THETA = 10000.0
ROPE_DIM = 64
ROPE_FREQS = ROPE_DIM // 4
Q_BLOCK = 128

A_HEADS = 4
A_DH = 64
A_DV = 2 * A_DH
LAMBDA_INIT_BASE = 0.8
LAMBDA_INIT_SPAN = 0.6
LAMBDA_INIT_RATE = 0.3
B_HEADS = 8
B_DK = 64
B_DV = 64
B_CHUNK = 32
C_HEADS = 4
C_DK = 128
C_DV = 128
C_CHUNK = 64
C_CONV = 5
D_HEADS = 8
D_KV_HEADS = 2
D_DH = 64
D_WINDOW = 128
P_HEADS = 8
P_NKEYS = 128
P_NEXPERTS = P_NKEYS * P_NKEYS
P_DQ = 256
P_TOPK = 16
P_TOKEN_BLOCK = 128

EVEN_SPLITS = (A_HEADS * 2 * A_DH, A_HEADS * 2 * A_DH, A_HEADS * A_DV,
               B_HEADS * B_DK, B_HEADS * B_DV, B_HEADS * B_DK, B_HEADS * B_DK, B_HEADS * B_DV)
EVEN_IN = sum(EVEN_SPLITS)
EVEN_OUT = A_HEADS * A_DV + B_HEADS * B_DV
C_QKV = C_HEADS * (2 * C_DK + C_DV)
ODD_SPLITS = (C_QKV, C_HEADS * C_DV, 4 * C_HEADS, D_HEADS * D_DH, 2 * D_KV_HEADS * D_DH)
ODD_IN = sum(ODD_SPLITS)
ODD_OUT = C_HEADS * C_DV + D_HEADS * D_DH

kernel_name = 'hybrid_diffusion_trunk_diffattn_hgrn2_gdn_swa_peer'


def split_cols(p, sizes):
    idx = [int(s) for s in np.cumsum(sizes)[:-1]]
    return jnp.split(p, idx, axis=-1)


def rmsnorm(x, w):
    xf = x.astype(jnp.float32)
    xf = xf * lax.rsqrt(jnp.mean(xf * xf, axis=-1, keepdims=True) + NORM_EPS)
    return (xf * w.astype(jnp.float32)).astype(x.dtype)


def l2norm(x):
    xf = x.astype(jnp.float32)
    return xf * lax.rsqrt(jnp.sum(xf * xf, axis=-1, keepdims=True) + NORM_EPS)


def modulate(x, w, shift, scale):
    return rmsnorm(x, w) * (1.0 + scale) + shift


def ada_split(cvec, w, b):
    return jnp.split(jax.nn.silu(cvec) @ w + b, ADA_CHUNKS, axis=-1)


def axial_rope_tables(rows):
    row = jnp.repeat(jnp.arange(rows, dtype=jnp.float32), GRID_W)
    col = jnp.tile(jnp.arange(GRID_W, dtype=jnp.float32), rows)
    inv = ROPE_THETA ** (-jnp.arange(ROPE_FREQS, dtype=jnp.float32) / ROPE_FREQS)
    ar = row[:, None] * inv[None, :]
    ac = col[:, None] * inv[None, :]
    ang = jnp.concatenate([ar, ar, ac, ac], axis=-1)
    return jnp.cos(ang), jnp.sin(ang)


def apply_rope(x, cos, sin):
    x1, x2, x3, x4 = jnp.split(x, 4, axis=-1)
    rot = jnp.concatenate([-x2, x1, -x4, x3], axis=-1)
    return (x * cos[:, None, :] + rot * sin[:, None, :]).astype(x.dtype)


def centred_depthwise_conv(x, w):
    pad = C_CONV // 2
    return lax.conv_general_dilated(x, w[:, None, :].astype(x.dtype), window_strides=(1,),
                                    padding=[(pad, pad)], dimension_numbers=('NWC', 'WIO', 'NWC'),
                                    feature_group_count=x.shape[-1])


def to_chunks(a, chunk):
    B, n = a.shape[:2]
    a = a.reshape((B, n // chunk, chunk) + a.shape[2:])
    return jnp.moveaxis(jnp.moveaxis(a, 1, 0), 2, 3)


def from_chunks(o, n):
    o = jnp.moveaxis(jnp.moveaxis(o, 3, 2), 0, 1)
    return o.reshape((o.shape[0], n) + o.shape[3:])


def gla_chunked(q, k, v, log_f, s0):
    n = q.shape[1]
    lower = jnp.tril(jnp.ones((B_CHUNK, B_CHUNK), dtype=bool))
    mid = B_CHUNK // 2

    def step(S, inp):
        qi, ki, vi, gi = inp
        b = jnp.cumsum(gi, axis=-2)
        ref = b[..., mid:mid + 1, :]
        att = jnp.einsum('bhqd,bhkd->bhqk', qi * jnp.exp(b - ref), ki * jnp.exp(ref - b))
        att = jnp.where(lower, att, 0.0)
        o = (jnp.einsum('bhqk,bhke->bhqe', att, vi)
             + jnp.einsum('bhqd,bhde->bhqe', qi * jnp.exp(b), S))
        b_last = b[..., -1:, :]
        S = (S * jnp.exp(b_last)[..., 0, :, None]
             + jnp.einsum('bhkd,bhke->bhde', ki * jnp.exp(b_last - b), vi))
        return S, o

    S, o = lax.scan(step, s0, tuple(to_chunks(a, B_CHUNK) for a in (q, k, v, log_f)))
    return from_chunks(o, n), S


def gated_delta_chunked(q, k, v, log_alpha, beta, s0):
    n = q.shape[1]
    dv = v.shape[-1]
    incl = jnp.tril(jnp.ones((C_CHUNK, C_CHUNK), dtype=bool))
    strict = jnp.tril(jnp.ones((C_CHUNK, C_CHUNK), dtype=bool), k=-1)
    eye = jnp.eye(C_CHUNK, dtype=jnp.float32)

    def step(S, inp):
        qi, ki, vi, gi, bi = inp
        g = jnp.cumsum(gi, axis=-1)
        decay = jnp.exp(jnp.where(incl, g[..., :, None] - g[..., None, :], -jnp.inf))
        kb = ki * bi[..., None]
        a_mat = jnp.where(strict, jnp.einsum('bhid,bhjd->bhij', kb, ki) * decay, 0.0) + eye
        rhs = jnp.concatenate([vi * bi[..., None], kb * jnp.exp(g)[..., None]], axis=-1)
        sol = lax.linalg.triangular_solve(a_mat, rhs, left_side=True, lower=True, unit_diagonal=True)
        u, w = sol[..., :dv], sol[..., dv:]
        v_new = u - jnp.einsum('bhcd,bhde->bhce', w, S)
        att = jnp.einsum('bhid,bhjd->bhij', qi, ki) * decay
        o = (jnp.einsum('bhcd,bhde->bhce', qi * jnp.exp(g)[..., None], S)
             + jnp.einsum('bhij,bhje->bhie', att, v_new))
        g_last = g[..., -1:]
        S = (S * jnp.exp(g_last)[..., None]
             + jnp.einsum('bhcd,bhce->bhde', ki * jnp.exp(g_last - g)[..., None], v_new))
        return S, o

    S, o = lax.scan(step, s0, tuple(to_chunks(a, C_CHUNK) for a in (q, k, v, log_alpha, beta)))
    return from_chunks(o, n), S


def bidirectional_scan(scan_fn, lat_fwd, lat_bwd, ctx_fwd, ctx_bwd, s0):
    o_lat, o_ctx = [], []
    for lat, ctxs, rev in ((lat_fwd, ctx_fwd, False), (lat_bwd, ctx_bwd, True)):
        if rev:
            lat = tuple(jnp.flip(a, axis=1) for a in lat)
            ctxs = tuple(jnp.flip(a, axis=1) for a in ctxs)
        oc, s_ctx = scan_fn(*ctxs, s0)
        ol, _ = scan_fn(*lat, s_ctx)
        if rev:
            oc, ol = jnp.flip(oc, axis=1), jnp.flip(ol, axis=1)
        o_lat.append(ol)
        o_ctx.append(oc)
    return o_lat[0] + o_lat[1], o_ctx[0] + o_ctx[1]


def diff_attn_probs(q, k, lam):
    s = jnp.einsum('bqhmd,bkhmd->bhmqk', q, k).astype(jnp.float32) * (A_DH ** -0.5)
    p = jax.nn.softmax(s, axis=-1)
    return p[:, :, 0] - lam * p[:, :, 1]


def diff_attention_latent(q, k, v, kc, vc, lam):
    B, T, H = q.shape[:3]
    k_all = jnp.concatenate([kc, k], axis=1)
    v_all = jnp.concatenate([vc, v], axis=1)
    nb = T // Q_BLOCK
    qb = jnp.moveaxis(q.reshape(B, nb, Q_BLOCK, H, 2, A_DH), 1, 0)

    def block(qi):
        a = diff_attn_probs(qi, k_all, lam)
        return jnp.einsum('bhqk,bkhe->bqhe', a.astype(v_all.dtype), v_all)

    o = lax.map(block, qb)
    return jnp.moveaxis(o, 0, 1).reshape(B, T, H, A_DV)


def diff_attention_ctx(qc, kc, vc, lam):
    a = diff_attn_probs(qc, kc, lam)
    return jnp.einsum('bhqk,bkhe->bqhe', a.astype(vc.dtype), vc)


def window_attention_latent(q, k, v, kc, vc, sink):
    B, T, H, d = q.shape
    G = H // D_KV_HEADS
    L = kc.shape[1]
    nb = T // Q_BLOCK
    band = Q_BLOCK + 2 * D_WINDOW
    pad = ((0, 0), (D_WINDOW, D_WINDOW), (0, 0), (0, 0))
    kp, vp = jnp.pad(k, pad), jnp.pad(v, pad)
    qb = jnp.moveaxis(q.reshape(B, nb, Q_BLOCK, D_KV_HEADS, G, d), 1, 0)
    rel = jnp.arange(band)[None, :] - D_WINDOW - jnp.arange(Q_BLOCK)[:, None]
    in_window = jnp.abs(rel) <= D_WINDOW
    sink_l = sink.astype(jnp.float32).reshape(1, D_KV_HEADS, G, 1, 1)
    scale = d ** -0.5

    def block(args):
        i, qi = args
        start = i * Q_BLOCK
        kb = lax.dynamic_slice_in_dim(kp, start, band, axis=1)
        vb = lax.dynamic_slice_in_dim(vp, start, band, axis=1)
        key_pos = start - D_WINDOW + jnp.arange(band)
        mask = in_window & ((key_pos >= 0) & (key_pos < T))[None, :]
        s_band = jnp.einsum('bqkgd,bnkd->bkgqn', qi, kb).astype(jnp.float32) * scale
        s_band = jnp.where(mask, s_band, -jnp.inf)
        s_ctx = jnp.einsum('bqkgd,bnkd->bkgqn', qi, kc).astype(jnp.float32) * scale
        logits = jnp.concatenate([jnp.broadcast_to(sink_l, s_ctx.shape[:-1] + (1,)), s_ctx, s_band], axis=-1)
        p = jax.nn.softmax(logits, axis=-1).astype(v.dtype)
        return (jnp.einsum('bkgqn,bnkd->bqkgd', p[..., 1:1 + L], vc)
                + jnp.einsum('bkgqn,bnkd->bqkgd', p[..., 1 + L:], vb))

    o = lax.map(block, (jnp.arange(nb), qb))
    return jnp.moveaxis(o, 0, 1).reshape(B, T, H, d)


def window_attention_ctx(qc, kc, vc, sink):
    B, L, H, d = qc.shape
    G = H // D_KV_HEADS
    s = jnp.einsum('bqkgd,bnkd->bkgqn', qc.reshape(B, L, D_KV_HEADS, G, d), kc).astype(jnp.float32) * d ** -0.5
    sink_l = jnp.broadcast_to(sink.astype(jnp.float32).reshape(1, D_KV_HEADS, G, 1, 1), s.shape[:-1] + (1,))
    p = jax.nn.softmax(jnp.concatenate([sink_l, s], axis=-1), axis=-1)[..., 1:]
    return jnp.einsum('bkgqn,bnkd->bqkgd', p.astype(vc.dtype), vc).reshape(B, L, H, d)


def peer_ffn(h, w_q, keys, u_tab, v_tab):
    B, T, D = h.shape
    hb = h.reshape(B * T // P_TOKEN_BLOCK, P_TOKEN_BLOCK, D)

    def block(xb):
        q = (xb @ w_q).reshape(P_TOKEN_BLOCK, P_HEADS, 2, P_DQ // 2)
        s = jnp.einsum('nhpd,hpkd->nhpk', q, keys).astype(jnp.float32)
        s_top, i_top = lax.top_k(s, P_TOPK)
        cand = (s_top[:, :, 0, :, None] + s_top[:, :, 1, None, :]).reshape(P_TOKEN_BLOCK, P_HEADS, P_TOPK * P_TOPK)
        cand_idx = (i_top[:, :, 0, :, None] * P_NKEYS + i_top[:, :, 1, None, :]).reshape(P_TOKEN_BLOCK, P_HEADS, P_TOPK * P_TOPK)
        best, pos = lax.top_k(cand, P_TOPK)
        idx = jnp.take_along_axis(cand_idx, pos, axis=-1)
        gate = jax.nn.softmax(best, axis=-1)
        u = u_tab[idx]
        v = v_tab[idx]
        act = jax.nn.gelu(jnp.einsum('nd,nhkd->nhk', xb, u).astype(jnp.float32), approximate=False)
        return jnp.einsum('nhk,nhkd->nd', (gate * act).astype(v.dtype), v)

    return lax.map(block, hb).reshape(B, T, D)


def even_mixer(layer, h, hc, w_in, w_out, diff_lambda, subln_w, hgrn_lb, hgrn_norm_w, cos, sin, need_ctx):
    B, T, _ = h.shape
    L = hc.shape[1]
    q_a, k_a, v_a, q_b, i_b, ff_b, fb_b, g_b = split_cols(h @ w_in, EVEN_SPLITS)
    qc_a, kc_a, vc_a, qc_b, ic_b, ffc_b, fbc_b, gc_b = split_cols(hc @ w_in, EVEN_SPLITS)

    lambda_init = LAMBDA_INIT_BASE - LAMBDA_INIT_SPAN * math.exp(-LAMBDA_INIT_RATE * layer)
    lam_f = diff_lambda.astype(jnp.float32)
    lam = jnp.exp(jnp.sum(lam_f[0] * lam_f[1])) - jnp.exp(jnp.sum(lam_f[2] * lam_f[3])) + lambda_init

    def qk_latent(t):
        return apply_rope(t.reshape(B, T, 2 * A_HEADS, A_DH), cos, sin).reshape(B, T, A_HEADS, 2, A_DH)

    kc = kc_a.reshape(B, L, A_HEADS, 2, A_DH)
    vc = vc_a.reshape(B, L, A_HEADS, A_DV)
    o_a = diff_attention_latent(qk_latent(q_a), qk_latent(k_a), v_a.reshape(B, T, A_HEADS, A_DV), kc, vc, lam)
    o_a = (rmsnorm(o_a, subln_w) * (1.0 - lambda_init)).astype(h.dtype)

    lb = jnp.cumsum(jax.nn.softmax(hgrn_lb.astype(jnp.float32), axis=0), axis=0)[layer]

    def hgrn_dirs(q, i, ff, fb, n):
        q = (jax.nn.silu(q.astype(jnp.float32)) * B_DK ** -0.5).reshape(B, n, B_HEADS, B_DK)
        i = i.astype(jnp.float32).reshape(B, n, B_HEADS, B_DV)
        out = []
        for f_logit in (ff, fb):
            f = (lb + (1.0 - lb) * jax.nn.sigmoid(f_logit.astype(jnp.float32))).reshape(B, n, B_HEADS, B_DK)
            out.append((q, 1.0 - f, i, jnp.log(f)))
        return out

    lat_f, lat_b = hgrn_dirs(q_b, i_b, ff_b, fb_b, T)
    ctx_f, ctx_b = hgrn_dirs(qc_b, ic_b, ffc_b, fbc_b, L)
    s0 = jnp.zeros((B, B_HEADS, B_DK, B_DV), jnp.float32)
    o_b, oc_b = bidirectional_scan(gla_chunked, lat_f, lat_b, ctx_f, ctx_b, s0)

    def hgrn_out(o, g, n):
        gate = jax.nn.silu(g.astype(jnp.float32).reshape(B, n, B_HEADS, B_DV))
        return (rmsnorm(o, hgrn_norm_w) * gate).reshape(B, n, B_HEADS * B_DV)

    y = jnp.concatenate([o_a.reshape(B, T, A_HEADS * A_DV), hgrn_out(o_b, g_b, T).astype(h.dtype)], axis=-1) @ w_out
    if not need_ctx:
        return y, None
    oc_a = rmsnorm(diff_attention_ctx(qc_a.reshape(B, L, A_HEADS, 2, A_DH), kc, vc, lam), subln_w) * (1.0 - lambda_init)
    yc = jnp.concatenate([oc_a.reshape(B, L, A_HEADS * A_DV).astype(hc.dtype),
                          hgrn_out(oc_b, gc_b, L).astype(hc.dtype)], axis=-1) @ w_out
    return y, yc


def odd_mixer(h, hc, w_in, w_out, conv_w, a_log, dt_bias, gdn_norm_w, sink, cos, sin, need_ctx):
    B, T, _ = h.shape
    L = hc.shape[1]
    qkv, z, gates, q_d, kv_d = split_cols(h @ w_in, ODD_SPLITS)
    qkvc, zc, gatesc, qc_d, kvc_d = split_cols(hc @ w_in, ODD_SPLITS)

    a_log_f = a_log.astype(jnp.float32)
    dt_f = dt_bias.astype(jnp.float32)

    def gdn_dirs(qkv_t, gates_t, n):
        qkv_t = jax.nn.silu(centred_depthwise_conv(qkv_t, conv_w))
        q, k, v = split_cols(qkv_t, (C_HEADS * C_DK, C_HEADS * C_DK, C_HEADS * C_DV))
        q = l2norm(q.reshape(B, n, C_HEADS, C_DK)) * C_DK ** -0.5
        k = l2norm(k.reshape(B, n, C_HEADS, C_DK))
        v = v.astype(jnp.float32).reshape(B, n, C_HEADS, C_DV)
        a_f, a_b, b_f, b_b = jnp.split(gates_t.astype(jnp.float32), 4, axis=-1)
        out = []
        for d, (a_t, b_t) in enumerate(((a_f, b_f), (a_b, b_b))):
            log_alpha = -jnp.exp(a_log_f[d]) * jax.nn.softplus(a_t + dt_f[d])
            out.append((q, k, v, log_alpha, jax.nn.sigmoid(b_t)))
        return out

    lat_f, lat_b = gdn_dirs(qkv, gates, T)
    ctx_f, ctx_b = gdn_dirs(qkvc, gatesc, L)
    s0 = jnp.zeros((B, C_HEADS, C_DK, C_DV), jnp.float32)
    o_c, oc_c = bidirectional_scan(gated_delta_chunked, lat_f, lat_b, ctx_f, ctx_b, s0)

    def gdn_out(o, zt, n):
        gate = jax.nn.silu(zt.astype(jnp.float32).reshape(B, n, C_HEADS, C_DV))
        return (rmsnorm(o, gdn_norm_w) * gate).reshape(B, n, C_HEADS * C_DV)

    k_d, v_d = jnp.split(kv_d, 2, axis=-1)
    kc_d, vc_d = jnp.split(kvc_d, 2, axis=-1)
    q_lat = apply_rope(q_d.reshape(B, T, D_HEADS, D_DH), cos, sin)
    k_lat = apply_rope(k_d.reshape(B, T, D_KV_HEADS, D_DH), cos, sin)
    kc = kc_d.reshape(B, L, D_KV_HEADS, D_DH)
    vc = vc_d.reshape(B, L, D_KV_HEADS, D_DH)
    o_d = window_attention_latent(q_lat, k_lat, v_d.reshape(B, T, D_KV_HEADS, D_DH), kc, vc, sink)

    y = jnp.concatenate([gdn_out(o_c, z, T).astype(h.dtype), o_d.reshape(B, T, D_HEADS * D_DH)], axis=-1) @ w_out
    if not need_ctx:
        return y, None
    oc_d = window_attention_ctx(qc_d.reshape(B, L, D_HEADS, D_DH), kc, vc, sink)
    yc = jnp.concatenate([gdn_out(oc_c, zc, L).astype(hc.dtype), oc_d.reshape(B, L, D_HEADS * D_DH)], axis=-1) @ w_out
    return y, yc


def setup_inputs(seed: int = 0) -> dict:
    key = jax.random.key(seed)
    ks = jax.random.split(key, 26)
    f32 = jnp.float32

    def nrm(k, shape, scale):
        return jax.random.normal(k, shape, f32) * scale

    dt = jnp.exp(jax.random.uniform(ks[18], (N_ODD, 2, C_HEADS), f32, math.log(1e-3), math.log(1e-1)))
    return {
        'x': nrm(ks[0], (BATCH, SEQ, D_MODEL), 1.0),
        'c': nrm(ks[1], (BATCH, D_MODEL), 1.0),
        'ctx': nrm(ks[2], (BATCH, CTX_LEN, D_MODEL), 1.0),
        'c_ctx': nrm(ks[3], (D_MODEL,), 1.0),
        'ada_w': nrm(ks[4], (DEPTH, D_MODEL, ADA_CHUNKS * D_MODEL), 0.5 * D_MODEL ** -0.5),
        'ada_b': nrm(ks[5], (DEPTH, ADA_CHUNKS * D_MODEL), 0.02),
        'norm_w': 1.0 + nrm(ks[6], (DEPTH, 2, D_MODEL), 0.02),
        'final_norm_w': 1.0 + nrm(ks[7], (D_MODEL,), 0.02),
        'even_w_in': nrm(ks[8], (N_EVEN, D_MODEL, EVEN_IN), D_MODEL ** -0.5),
        'even_w_out': nrm(ks[9], (N_EVEN, EVEN_OUT, D_MODEL), EVEN_OUT ** -0.5),
        'diff_lambda': nrm(ks[10], (N_EVEN, 4, A_DH), 0.1),
        'diff_subln_w': 1.0 + nrm(ks[11], (N_EVEN, A_DV), 0.02),
        'hgrn_lb': nrm(ks[12], (DEPTH + 1, B_HEADS * B_DK), 0.1),
        'hgrn_norm_w': 1.0 + nrm(ks[13], (N_EVEN, B_DV), 0.02),
        'odd_w_in': nrm(ks[14], (N_ODD, D_MODEL, ODD_IN), D_MODEL ** -0.5),
        'odd_w_out': nrm(ks[15], (N_ODD, ODD_OUT, D_MODEL), ODD_OUT ** -0.5),
        'gdn_conv_w': nrm(ks[16], (N_ODD, C_CONV, C_QKV), C_CONV ** -0.5),
        'gdn_a_log': jnp.log(jax.random.uniform(ks[17], (N_ODD, 2, C_HEADS), f32, 1.0, 16.0)),
        'gdn_dt_bias': dt + jnp.log(-jnp.expm1(-dt)),
        'gdn_norm_w': 1.0 + nrm(ks[19], (N_ODD, C_DV), 0.02),
        'swa_sink': nrm(ks[20], (N_ODD, D_HEADS), 0.5),
        'peer_w_q': nrm(ks[21], (DEPTH, D_MODEL, P_HEADS * P_DQ), D_MODEL ** -0.5),
        'peer_keys': nrm(ks[22], (DEPTH, P_HEADS, 2, P_NKEYS, P_DQ // 2), (P_DQ // 2) ** -0.5),
        'peer_u': nrm(ks[23], (DEPTH, P_NEXPERTS, D_MODEL), D_MODEL ** -0.5),
        'peer_v': nrm(ks[24], (DEPTH, P_NEXPERTS, D_MODEL), 0.25),
    }


def reference(x, c, ctx, c_ctx, ada_w, ada_b, norm_w, final_norm_w, even_w_in, even_w_out, diff_lambda,
              diff_subln_w, hgrn_lb, hgrn_norm_w, odd_w_in, odd_w_out, gdn_conv_w, gdn_a_log, gdn_dt_bias,
              gdn_norm_w, swa_sink, peer_w_q, peer_keys, peer_u, peer_v):
    T = x.shape[1]
    ROWS = T // GRID_W
    cos, sin = axial_rope_tables(ROWS)
    xc = ctx
    for layer in range(DEPTH):
        need_ctx = layer < DEPTH - 1
        w_ada, b_ada = ada_w[layer], ada_b[layer]
        sh1, sc1, g1, sh2, sc2, g2 = [m[:, None, :] for m in ada_split(c, w_ada, b_ada)]
        sh1c, sc1c, g1c, sh2c, sc2c, g2c = ada_split(c_ctx, w_ada, b_ada)
        h = modulate(x, norm_w[layer, 0], sh1, sc1)
        hc = modulate(xc, norm_w[layer, 0], sh1c, sc1c)
        if layer % 2 == 0:
            e = layer // 2
            y, yc = even_mixer(layer, h, hc, even_w_in[e], even_w_out[e], diff_lambda[e], diff_subln_w[e],
                               hgrn_lb, hgrn_norm_w[e], cos, sin, need_ctx)
        else:
            o = layer // 2
            y, yc = odd_mixer(h, hc, odd_w_in[o], odd_w_out[o], gdn_conv_w[o], gdn_a_log[o], gdn_dt_bias[o],
                              gdn_norm_w[o], swa_sink[o], cos, sin, need_ctx)
        x = x + g1 * y
        x = x + g2 * peer_ffn(modulate(x, norm_w[layer, 1], sh2, sc2),
                              peer_w_q[layer], peer_keys[layer], peer_u[layer], peer_v[layer])
        if need_ctx:
            xc = xc + g1c * yc
            xc = xc + g2c * peer_ffn(modulate(xc, norm_w[layer, 1], sh2c, sc2c),
                                     peer_w_q[layer], peer_keys[layer], peer_u[layer], peer_v[layer])
    return rmsnorm(x, final_norm_w)
```

```cpp
#include <hip/hip_runtime.h>
#include <hip/hip_cooperative_groups.h>
#include <cstdio>
#include <type_traits>
namespace cg = cooperative_groups;

#ifndef SINGLE_LAUNCH
#define SINGLE_LAUNCH 1
#endif

typedef unsigned short bf16_t;
using bf16x8 = __attribute__((ext_vector_type(8))) short;
using s16x4 = __attribute__((ext_vector_type(4))) short;
using f32x4 = __attribute__((ext_vector_type(4))) float;
using u32x4 = __attribute__((ext_vector_type(4))) unsigned;
typedef __attribute__((ext_vector_type(2))) __bf16 bf2_t;
#define DI __device__ __forceinline__

constexpr int NB = 32, TT = 2048, LL = 256, DM = 1024;
constexpr int NLAT = NB * TT, NCTX = NB * LL, NTOK = NLAT + NCTX;
constexpr int LD0 = 4096, LD1 = 2944;
constexpr int SMEM_BYTES = 79360;
constexpr int NTHREADS = 256;
constexpr int NPHASES = 17;

struct Params {
  const float *x, *c, *ctx, *c_ctx, *ada_w, *ada_b, *norm_w, *final_norm_w, *even_w_in, *even_w_out, *diff_lambda,
      *diff_subln_w, *hgrn_lb, *hgrn_norm_w, *odd_w_in, *odd_w_out, *gdn_conv_w, *gdn_a_log, *gdn_dt_bias, *gdn_norm_w,
      *swa_sink, *peer_w_q, *peer_keys, *peer_u, *peer_v;
  float* out;
  bf16_t *proj, *mix, *wt_in0, *wt_out0, *wt_in1, *wt_out1, *wt_q, *keys_bf, *u_bf, *v_bf, *pq, *gdn_of, *gdn_ob;
  float *xc, *mod, *rope, *pgate;
  int* pidx;
  unsigned* counters;
};

DI int get_tid() {
  int t = threadIdx.x;
  asm volatile("" : "+v"(t));
  return t;
}
DI bf16_t f2bf(float x) {
  unsigned u = __float_as_uint(x);
  u += 0x7fffu + ((u >> 16) & 1u);
  return (bf16_t)(u >> 16);
}
DI float bf2f(bf16_t h) { return __uint_as_float(((unsigned)h) << 16); }
DI unsigned pack2(float a, float b) { return (unsigned)f2bf(a) | ((unsigned)f2bf(b) << 16); }
DI f32x4 mfma16(bf16x8 a, bf16x8 b, f32x4 c) { return __builtin_amdgcn_mfma_f32_16x16x32_bf16(a, b, c, 0, 0, 0); }
DI bf16x8 ldfrag(const bf16_t* p) { return *(const bf16x8*)p; }
DI bf16x8 ldfrag_perm(const bf16_t* row, int ks, int q) {
  s16x4 lo = *(const s16x4*)(row + ks * 32 + q * 4);
  s16x4 hi = *(const s16x4*)(row + ks * 32 + 16 + q * 4);
  return __builtin_shufflevector(lo, hi, 0, 1, 2, 3, 4, 5, 6, 7);
}
DI bf16x8 packfrag(f32x4 a, f32x4 b) {
  unsigned w0 = pack2(a[0], a[1]), w1 = pack2(a[2], a[3]), w2 = pack2(b[0], b[1]), w3 = pack2(b[2], b[3]);
  typedef __attribute__((ext_vector_type(4))) unsigned u32x4;
  u32x4 v = {w0, w1, w2, w3};
  return __builtin_bit_cast(bf16x8, v);
}
DI float siluf(float x) { return x / (1.f + expf(-x)); }
DI float sigmoidf_(float x) { return 1.f / (1.f + expf(-x)); }
DI float wave_sum(float v) {
#pragma unroll
  for (int o = 32; o >= 1; o >>= 1) v += __shfl_xor(v, o);
  return v;
}
DI float grp16_sum(float v) {
#pragma unroll
  for (int o = 8; o >= 1; o >>= 1) v += __shfl_xor(v, o);
  return v;
}
DI float grp16_max(float v) {
#pragma unroll
  for (int o = 8; o >= 1; o >>= 1) v = fmaxf(v, __shfl_xor(v, o));
  return v;
}
DI const float* modp(const Params& p, int layer, int vec, int chunk) {
  return p.mod + ((size_t)(layer * 33 + vec) * 6 + chunk) * 1024;
}
DI int vec_of_row(int row) { return row < NLAT ? (row >> 11) : 32; }

DI void transpose_job(const float* W, int nsrc, bf16_t* Wt, int n0, int k0, int mapmode, float* tile) {
  const int tid = get_tid();
  __syncthreads();
#pragma unroll 4
  for (int i = 0; i < 16; ++i) {
    int kk = (tid >> 6) + 4 * i, nn = tid & 63;
    int nd = n0 + nn, ns = nd;
    if (mapmode == 1) ns = nd < 2048 ? nd : (nd < 2816 ? nd + 16 : (nd < 2832 ? nd - 768 : -1));
    float v = ns >= 0 ? W[(size_t)(k0 + kk) * nsrc + ns] : 0.f;
    tile[kk * 65 + nn] = v;
  }
  __syncthreads();
#pragma unroll 4
  for (int i = 0; i < 16; ++i) {
    int nn = (tid >> 6) + 4 * i, kk = tid & 63;
    Wt[(size_t)(n0 + nn) * 1024 + k0 + kk] = f2bf(tile[kk * 65 + nn]);
  }
}

DI void convert_seg(const float* src, bf16_t* dst, size_t n4) {
  size_t stride = (size_t)gridDim.x * NTHREADS;
  for (size_t i = (size_t)blockIdx.x * NTHREADS + get_tid(); i < n4; i += stride) {
    float4 v = ((const float4*)src)[i];
    uint2 o;
    o.x = pack2(v.x, v.y);
    o.y = pack2(v.z, v.w);
    ((uint2*)dst)[i] = o;
  }
}

DI void phase_setup(const Params& p, char* smem) {
  const int tid = get_tid();
  float* sm = (float*)smem;
  if (blockIdx.x == 0 && tid < 64) p.counters[tid] = 0u;
  for (int i = blockIdx.x * NTHREADS + tid; i < 64 * 16; i += gridDim.x * NTHREADS) {
    int pos = i >> 4, f = i & 15;
    float inv = powf(10000.f, -(float)f / 16.f);
    float ang = (float)pos * inv;
    p.rope[i * 2] = cosf(ang);
    p.rope[i * 2 + 1] = sinf(ang);
  }
  for (int job = blockIdx.x; job < 192; job += gridDim.x) {
    int layer = job / 96, col0 = (job % 96) * 64;
    float acc[33];
#pragma unroll
    for (int v = 0; v < 33; ++v) acc[v] = 0.f;
    float* sc = sm;
    float* red = sm + 33 * 256;
    const int col = col0 + (tid & 63), kq = tid >> 6;
    for (int kc = 0; kc < 4; ++kc) {
      __syncthreads();
      for (int idx = tid; idx < 33 * 256; idx += NTHREADS) {
        int v = idx >> 8, kk = idx & 255, k = kc * 256 + kk;
        float cv = v < 32 ? p.c[v * 1024 + k] : p.c_ctx[k];
        sc[idx] = siluf(cv);
      }
      __syncthreads();
      for (int kk = kq * 64; kk < kq * 64 + 64; ++kk) {
        float w = p.ada_w[((size_t)layer * 1024 + kc * 256 + kk) * 6144 + col];
#pragma unroll
        for (int v = 0; v < 33; ++v) acc[v] += sc[v * 256 + kk] * w;
      }
    }
    __syncthreads();
#pragma unroll
    for (int v = 0; v < 33; ++v) red[(kq * 33 + v) * 64 + (tid & 63)] = acc[v];
    __syncthreads();
    for (int idx = tid; idx < 33 * 64; idx += NTHREADS) {
      int v = idx >> 6, cc = idx & 63;
      float s = p.ada_b[layer * 6144 + col0 + cc];
#pragma unroll
      for (int k4 = 0; k4 < 4; ++k4) s += red[(k4 * 33 + v) * 64 + cc];
      p.mod[(size_t)(layer * 33 + v) * 6144 + col0 + cc] = s;
    }
    __syncthreads();
  }
  {
    const int J0 = 1024, J1 = J0 + 256, J2 = J1 + 736, J3 = J2 + 256, J4 = J3 + 1024;
    for (int job = blockIdx.x; job < J4; job += gridDim.x) {
      if (job < J0) {
        transpose_job(p.even_w_in, 4096, p.wt_in0, (job >> 4) * 64, (job & 15) * 64, 0, sm);
      } else if (job < J1) {
        int j = job - J0;
        transpose_job(p.even_w_out, 1024, p.wt_out0, (j >> 4) * 64, (j & 15) * 64, 0, sm);
      } else if (job < J2) {
        int j = job - J1;
        transpose_job(p.odd_w_in, 2832, p.wt_in1, (j >> 4) * 64, (j & 15) * 64, 1, sm);
      } else if (job < J3) {
        int j = job - J2;
        transpose_job(p.odd_w_out, 1024, p.wt_out1, (j >> 4) * 64, (j & 15) * 64, 0, sm);
      } else {
        int j = job - J3;
        int layer = j >> 9;
        j &= 511;
        transpose_job(p.peer_w_q + (size_t)layer * 1024 * 2048, 2048, p.wt_q + (size_t)layer * 2048 * 1024,
                      (j >> 4) * 64, (j & 15) * 64, 0, sm);
      }
    }
  }
  convert_seg(p.peer_keys, p.keys_bf, (size_t)2 * 8 * 2 * 128 * 128 / 4);
  convert_seg(p.peer_u, p.u_bf, (size_t)2 * 16384 * 1024 / 4);
  convert_seg(p.peer_v, p.v_bf, (size_t)2 * 16384 * 1024 / 4);
}

DI void phase_modulate(const Params& p, const float* xlat, const float* xctx, int nrows, int layer, int which) {
  const int lane = get_tid() & 63, wave = get_tid() >> 6;
  const float* nw = p.norm_w + (layer * 2 + which) * 1024;
  for (int row = blockIdx.x * 4 + wave; row < nrows; row += gridDim.x * 4) {
    const float* xr = row < NLAT ? xlat + (size_t)row * 1024 : xctx + (size_t)(row - NLAT) * 1024;
    int vec = vec_of_row(row);
    const float* sh = modp(p, layer, vec, which * 3 + 0);
    const float* sc = modp(p, layer, vec, which * 3 + 1);
    f32x4 v[4];
    float ss = 0.f;
#pragma unroll
    for (int i = 0; i < 4; ++i) {
      v[i] = *(const f32x4*)(xr + i * 256 + lane * 4);
      ss += v[i][0] * v[i][0] + v[i][1] * v[i][1] + v[i][2] * v[i][2] + v[i][3] * v[i][3];
    }
    ss = wave_sum(ss);
    float rstd = rsqrtf(ss * (1.f / 1024.f) + 1e-6f);
#pragma unroll
    for (int i = 0; i < 4; ++i) {
      int c0 = i * 256 + lane * 4;
      float4 w = *(const float4*)(nw + c0), s1 = *(const float4*)(sc + c0), s0 = *(const float4*)(sh + c0);
      float a = v[i][0] * rstd * w.x * (1.f + s1.x) + s0.x;
      float b = v[i][1] * rstd * w.y * (1.f + s1.y) + s0.y;
      float c = v[i][2] * rstd * w.z * (1.f + s1.z) + s0.z;
      float d = v[i][3] * rstd * w.w * (1.f + s1.w) + s0.w;
      uint2 o;
      o.x = pack2(a, b);
      o.y = pack2(c, d);
      *(uint2*)(p.mix + (size_t)row * 1024 + c0) = o;
    }
  }
}

enum { EPI_IN0 = 0, EPI_IN1 = 1, EPI_OUT = 2, EPI_PQ = 3 };
template <int EPI>
DI void phase_gemm(const Params& p, const bf16_t* A, const bf16_t* Bt, int M, int N, char* smem, int layer,
                           const float* xin_lat, const float* xin_ctx) {
  bf16_t* sA = (bf16_t*)smem;
  bf16_t* sB = sA + 128 * 72;
  const int tid = get_tid(), lane = tid & 63, wave = tid >> 6, q = lane >> 4, l15 = lane & 15;
  const int wm = wave >> 1, wn = wave & 1;
  const int ntn = N / 128, ntm = M / 128;
  const int lr = tid >> 3, lc = (tid & 7) * 8;
  for (int tile = blockIdx.x; tile < ntm * ntn; tile += gridDim.x) {
    const int tm = tile / ntn, tn = tile % ntn;
    f32x4 acc[4][4];
#pragma unroll
    for (int i = 0; i < 4; ++i)
#pragma unroll
      for (int j = 0; j < 4; ++j) acc[i][j] = f32x4{0.f, 0.f, 0.f, 0.f};
    const bf16_t* Ag = A + (size_t)(tm * 128 + lr) * 1024 + lc;
    const bf16_t* Bg = Bt + (size_t)(tn * 128 + lr) * 1024 + lc;
    u32x4 ra[4], rb[4];
#pragma unroll
    for (int i = 0; i < 4; ++i) {
      ra[i] = *(const u32x4*)(Ag + (size_t)i * 32 * 1024);
      rb[i] = *(const u32x4*)(Bg + (size_t)i * 32 * 1024);
    }
    for (int kt = 0; kt < 16; ++kt) {
      __syncthreads();
#pragma unroll
      for (int i = 0; i < 4; ++i) {
        *(u32x4*)(sA + (lr + 32 * i) * 72 + lc) = ra[i];
        *(u32x4*)(sB + (lr + 32 * i) * 72 + lc) = rb[i];
      }
      __syncthreads();
      if (kt < 15) {
#pragma unroll
        for (int i = 0; i < 4; ++i) {
          ra[i] = *(const u32x4*)(Ag + (size_t)i * 32 * 1024 + (kt + 1) * 64);
          rb[i] = *(const u32x4*)(Bg + (size_t)i * 32 * 1024 + (kt + 1) * 64);
        }
      }
#pragma unroll
      for (int ks = 0; ks < 2; ++ks) {
        bf16x8 af[4], bfr[4];
#pragma unroll
        for (int i = 0; i < 4; ++i) {
          af[i] = ldfrag(sA + (wm * 64 + i * 16 + l15) * 72 + ks * 32 + q * 8);
          bfr[i] = ldfrag(sB + (wn * 64 + i * 16 + l15) * 72 + ks * 32 + q * 8);
        }
#pragma unroll
        for (int i = 0; i < 4; ++i)
#pragma unroll
          for (int j = 0; j < 4; ++j) acc[i][j] = mfma16(af[i], bfr[j], acc[i][j]);
      }
    }
    const int colbase = tn * 128 + wn * 64;
    const int rowbase = tm * 128 + wm * 64;
    if (EPI == EPI_IN0 || EPI == EPI_IN1) {
      const int ld = EPI == EPI_IN0 ? LD0 : LD1;
      bool ropegrp = EPI == EPI_IN0 ? (colbase < 1024) : (colbase >= 2048 && colbase < 2688);
      bool lat = rowbase < NLAT;
      if (ropegrp && lat) {
#pragma unroll
        for (int i = 0; i < 4; ++i)
#pragma unroll
          for (int r = 0; r < 4; ++r) {
            int row = rowbase + i * 16 + q * 4 + r;
            int t = row & 2047, gr = t >> 6, gc = t & 63;
            float2 cr = *(const float2*)(p.rope + (gr * 16 + l15) * 2);
            float2 cc = *(const float2*)(p.rope + (gc * 16 + l15) * 2);
            float x1 = acc[i][0][r], x2 = acc[i][1][r], x3 = acc[i][2][r], x4 = acc[i][3][r];
            bf16_t* o = p.proj + (size_t)row * ld + colbase + l15;
            o[0] = f2bf(x1 * cr.x - x2 * cr.y);
            o[16] = f2bf(x2 * cr.x + x1 * cr.y);
            o[32] = f2bf(x3 * cc.x - x4 * cc.y);
            o[48] = f2bf(x4 * cc.x + x3 * cc.y);
          }
      } else {
#pragma unroll
        for (int i = 0; i < 4; ++i)
#pragma unroll
          for (int j = 0; j < 4; ++j)
#pragma unroll
            for (int r = 0; r < 4; ++r) {
              int row = rowbase + i * 16 + q * 4 + r, col = colbase + j * 16 + l15;
              if (EPI == EPI_IN0 || col < 2832) p.proj[(size_t)row * ld + col] = f2bf(acc[i][j][r]);
            }
      }
    } else if (EPI == EPI_OUT) {
#pragma unroll
      for (int i = 0; i < 4; ++i)
#pragma unroll
        for (int r = 0; r < 4; ++r) {
          int row = rowbase + i * 16 + q * 4 + r;
          const float* g1 = modp(p, layer, vec_of_row(row), 2);
          const float* xi = row < NLAT ? xin_lat + (size_t)row * 1024 : xin_ctx + (size_t)(row - NLAT) * 1024;
          float* xo = row < NLAT ? p.out + (size_t)row * 1024 : p.xc + (size_t)(row - NLAT) * 1024;
#pragma unroll
          for (int j = 0; j < 4; ++j) {
            int col = colbase + j * 16 + l15;
            xo[col] = xi[col] + g1[col] * acc[i][j][r];
          }
        }
    } else {
#pragma unroll
      for (int i = 0; i < 4; ++i)
#pragma unroll
        for (int j = 0; j < 4; ++j)
#pragma unroll
          for (int r = 0; r < 4; ++r) {
            int row = rowbase + i * 16 + q * 4 + r, col = colbase + j * 16 + l15;
            p.pq[(size_t)row * 2048 + col] = f2bf(acc[i][j][r]);
          }
    }
  }
}

template <int DV, int NC>
DI void flash_item(char* smem, const bf16_t* Qb, int ld, const bf16_t* Kc, const bf16_t* Vc, const bf16_t* Kl,
                   const bf16_t* Vl, int l_lo, int l_hi, int qpos0, int window, float sink, float scale,
                   f32x4 (&o)[NC][DV / 16], float (&m)[NC][4], float (&l)[NC][4]) {
  bf16_t* sK = (bf16_t*)smem;
  bf16_t* sVt = sK + NC * 64 * 72;
  bf16_t* sP = sVt + DV * 72;
  const int tid0 = get_tid();
  bf16x8 qf[NC][2];
  {
  const int lane = tid0 & 63, wave = tid0 >> 6, q = lane >> 4, l15 = lane & 15;
#pragma unroll
  for (int c = 0; c < NC; ++c)
#pragma unroll
    for (int ks = 0; ks < 2; ++ks)
      qf[c][ks] = *(const bf16x8*)(Qb + (size_t)(wave * 16 + l15) * ld + c * 64 + ks * 32 + q * 8);
  }
#pragma unroll
  for (int c = 0; c < NC; ++c) {
#pragma unroll
    for (int r = 0; r < 4; ++r) {
      m[c][r] = sink;
      l[c][r] = sink == -INFINITY ? 0.f : 1.f;
    }
#pragma unroll
    for (int n = 0; n < DV / 16; ++n) o[c][n] = f32x4{0.f, 0.f, 0.f, 0.f};
  }
  const int nlt = l_hi > l_lo ? (l_hi - l_lo) / 64 : 0;
  const int ntiles = 4 + nlt;
  for (int it = 0; it < ntiles; ++it) {
    int tid = tid0;
    asm volatile("" : "+v"(tid));
    const int lane = tid & 63, wave = tid >> 6, q = lane >> 4, l15 = lane & 15;
    bf16_t* myP = sP + wave * NC * 16 * 72;
    const bf16_t *Kr, *Vr;
    int kpos0;
    if (it < 4) {
      Kr = Kc + (size_t)(it * 64) * ld;
      Vr = Vc + (size_t)(it * 64) * ld;
      kpos0 = -(1 << 28);
    } else {
      kpos0 = l_lo + (it - 4) * 64;
      Kr = Kl + (size_t)kpos0 * ld;
      Vr = Vl + (size_t)kpos0 * ld;
    }
    __syncthreads();
    {
      int key = tid >> 2, part = tid & 3;
#pragma unroll
      for (int c = 0; c < NC; ++c) {
        const bf16_t* s = Kr + (size_t)key * ld + c * 64 + part * 16;
        uint4 a = *(const uint4*)s, b = *(const uint4*)(s + 8);
        *(uint4*)(sK + (c * 64 + key) * 72 + part * 16) = a;
        *(uint4*)(sK + (c * 64 + key) * 72 + part * 16 + 8) = b;
      }
      int vkey = tid & 63, cg4 = tid >> 6;
#pragma unroll
      for (int i = 0; i < DV / 32; ++i) {
        int e0 = (cg4 + 4 * i) * 8;
        uint4 v = *(const uint4*)(Vr + (size_t)vkey * ld + e0);
        unsigned w[4] = {v.x, v.y, v.z, v.w};
#pragma unroll
        for (int j = 0; j < 4; ++j) {
          sVt[(e0 + 2 * j) * 72 + vkey] = (bf16_t)(w[j] & 0xffffu);
          sVt[(e0 + 2 * j + 1) * 72 + vkey] = (bf16_t)(w[j] >> 16);
        }
      }
    }
    __syncthreads();
#pragma unroll
    for (int c = 0; c < NC; ++c) {
      f32x4 s[4];
#pragma unroll
      for (int nt = 0; nt < 4; ++nt) {
        s[nt] = f32x4{0.f, 0.f, 0.f, 0.f};
#pragma unroll
        for (int ks = 0; ks < 2; ++ks)
          s[nt] = mfma16(qf[c][ks], ldfrag(sK + (c * 64 + nt * 16 + l15) * 72 + ks * 32 + q * 8), s[nt]);
      }
#pragma unroll
      for (int r = 0; r < 4; ++r) {
        float mx = -INFINITY;
#pragma unroll
        for (int nt = 0; nt < 4; ++nt) {
          float v = s[nt][r] * scale;
          if (window >= 0) {
            int kp = kpos0 + nt * 16 + l15, qp = qpos0 + wave * 16 + q * 4 + r;
            int d = kp - qp;
            if (kpos0 >= 0 && (d > window || d < -window)) v = -INFINITY;
          }
          s[nt][r] = v;
          mx = fmaxf(mx, v);
        }
        mx = grp16_max(mx);
        float mn = fmaxf(m[c][r], mx);
        float alpha = (mn == -INFINITY) ? 1.f : __expf(m[c][r] - mn);
        float rs = 0.f;
#pragma unroll
        for (int nt = 0; nt < 4; ++nt) {
          float pv = (mn == -INFINITY) ? 0.f : __expf(s[nt][r] - mn);
          s[nt][r] = pv;
          rs += pv;
        }
        rs = grp16_sum(rs);
        l[c][r] = l[c][r] * alpha + rs;
        m[c][r] = mn;
#pragma unroll
        for (int n = 0; n < DV / 16; ++n) o[c][n][r] *= alpha;
#pragma unroll
        for (int nt = 0; nt < 4; ++nt) myP[(c * 16 + q * 4 + r) * 72 + nt * 16 + l15] = f2bf(s[nt][r]);
      }
    }
    __syncthreads();
#pragma unroll
    for (int ks = 0; ks < 2; ++ks) {
      bf16x8 pf[NC];
#pragma unroll
      for (int c = 0; c < NC; ++c) pf[c] = ldfrag(myP + (c * 16 + l15) * 72 + ks * 32 + q * 8);
#pragma unroll
      for (int n = 0; n < DV / 16; ++n) {
        bf16x8 vf = ldfrag(sVt + (n * 16 + l15) * 72 + ks * 32 + q * 8);
#pragma unroll
        for (int c = 0; c < NC; ++c) o[c][n] = mfma16(pf[c], vf, o[c][n]);
      }
    }
  }
}

DI void diff_item(const Params& p, char* smem, int b, int h, int qb, bool is_ctx, float lam) {
  const int lane = get_tid() & 63, wave = get_tid() >> 6, q = lane >> 4, l15 = lane & 15;
  const int ctxrow0 = NLAT + b * LL;
  const int qrow0 = is_ctx ? ctxrow0 + qb * 64 : b * TT + qb * 64;
  const bf16_t* Qb = p.proj + (size_t)qrow0 * LD0 + h * 128;
  const bf16_t* Kc = p.proj + (size_t)ctxrow0 * LD0 + 512 + h * 128;
  const bf16_t* Vc = p.proj + (size_t)ctxrow0 * LD0 + 1024 + h * 128;
  const bf16_t* Kl = p.proj + (size_t)(b * TT) * LD0 + 512 + h * 128;
  const bf16_t* Vl = p.proj + (size_t)(b * TT) * LD0 + 1024 + h * 128;
  f32x4 o[2][8];
  float m[2][4], l[2][4];
  flash_item<128, 2>(smem, Qb, LD0, Kc, Vc, Kl, Vl, 0, is_ctx ? 0 : TT, 0, -1, -INFINITY, 0.125f, o, m, l);
  const float* sw = p.diff_subln_w;
#pragma unroll
  for (int r = 0; r < 4; ++r) {
    float i0 = 1.f / l[0][r], i1 = lam / l[1][r];
    float ss = 0.f;
    float val[8];
#pragma unroll
    for (int n = 0; n < 8; ++n) {
      val[n] = o[0][n][r] * i0 - o[1][n][r] * i1;
      ss += val[n] * val[n];
    }
    ss = grp16_sum(ss);
    float rstd = rsqrtf(ss * (1.f / 128.f) + 1e-6f) * 0.8f;
    int row = qrow0 + wave * 16 + q * 4 + r;
#pragma unroll
    for (int n = 0; n < 8; ++n) {
      int e = n * 16 + l15;
      p.mix[(size_t)row * 1024 + h * 128 + e] = f2bf(val[n] * rstd * sw[e]);
    }
  }
}

DI void swa_item(const Params& p, char* smem, int b, int h, int qb) {
  const int lane = get_tid() & 63, wave = get_tid() >> 6, q = lane >> 4, l15 = lane & 15;
  const int kvh = h >> 2;
  const int ctxrow0 = NLAT + b * LL;
  const int qrow0 = b * TT + qb * 64;
  const bf16_t* Qb = p.proj + (size_t)qrow0 * LD1 + 2048 + h * 64;
  const bf16_t* Kc = p.proj + (size_t)ctxrow0 * LD1 + 2560 + kvh * 64;
  const bf16_t* Vc = p.proj + (size_t)ctxrow0 * LD1 + 2688 + kvh * 64;
  const bf16_t* Kl = p.proj + (size_t)(b * TT) * LD1 + 2560 + kvh * 64;
  const bf16_t* Vl = p.proj + (size_t)(b * TT) * LD1 + 2688 + kvh * 64;
  int lo = qb * 64 - 128, hi = qb * 64 + 64 + 128;
  if (lo < 0) lo = 0;
  if (hi > TT) hi = TT;
  f32x4 o[1][4];
  float m[1][4], l[1][4];
  flash_item<64, 1>(smem, Qb, LD1, Kc, Vc, Kl, Vl, lo, hi, qb * 64, 128, p.swa_sink[h], 0.125f, o, m, l);
#pragma unroll
  for (int r = 0; r < 4; ++r) {
    float inv = 1.f / l[0][r];
    int row = qrow0 + wave * 16 + q * 4 + r;
#pragma unroll
    for (int n = 0; n < 4; ++n) p.mix[(size_t)row * 1024 + 512 + h * 64 + n * 16 + l15] = f2bf(o[0][n][r] * inv);
  }
}

DI void hgrn_item(const Params& p, char* smem, int b, int head) {
  bf16_t* sQt = (bf16_t*)smem;
  bf16_t* sKt = sQt + 32 * 72;
  bf16_t* sQS = sKt + 32 * 72;
  bf16_t* sKST = sQS + 32 * 72;
  bf16_t* sVT = sKST + 64 * 40;
  bf16_t* sAtt = sVT + 64 * 40;
  bf16_t* sST = sAtt + 32 * 40;
  float* sO = (float*)(sST + 64 * 72);
  float* sGs = sO + 32 * 65;
  float* sG16 = sGs + 256;
  float* sEB = sG16 + 64;
  const int tid0 = get_tid();
  const int ch = head * 64 + (tid0 & 63);
  float lb;
  {
    float a0 = p.hgrn_lb[ch], a1 = p.hgrn_lb[512 + ch], a2 = p.hgrn_lb[1024 + ch];
    float mx = fmaxf(a0, fmaxf(a1, a2));
    float e0 = expf(a0 - mx), e1 = expf(a1 - mx), e2 = expf(a2 - mx);
    lb = e0 / (e0 + e1 + e2);
  }
  for (int dir = 0; dir < 2; ++dir) {
    const bool rev = dir == 1;
    f32x4 S[4];
#pragma unroll
    for (int n = 0; n < 4; ++n) S[n] = f32x4{0.f, 0.f, 0.f, 0.f};
    __syncthreads();
    for (int i = tid0; i < 64 * 72; i += NTHREADS) sST[i] = 0;
    for (int step = 0; step < 72; ++step) {
      int tid = tid0;
      asm volatile("" : "+v"(tid));
      const int lane = tid & 63, wave = tid >> 6, q = lane >> 4, l15 = lane & 15;
      const int c = tid & 63, tg = tid >> 6;
      const bool isctx = step < 8;
      const int n = isctx ? LL : TT;
      const int j = isctx ? step : step - 8;
      const int rowseg = isctx ? NLAT + b * LL : b * TT;
      float qv[8], kk[8], vv[8], cs[8];
      float run = 0.f;
#pragma unroll
      for (int jj = 0; jj < 8; ++jj) {
        int pp = tg * 8 + jj;
        int tok = rev ? n - 1 - (32 * j + pp) : 32 * j + pp;
        const bf16_t* pr = p.proj + (size_t)(rowseg + tok) * LD0;
        float qr = bf2f(pr[1536 + ch]), ir = bf2f(pr[2048 + ch]), fl = bf2f(pr[(rev ? 3072 : 2560) + ch]);
        qv[jj] = siluf(qr) * 0.125f;
        float f = lb + (1.f - lb) * sigmoidf_(fl);
        kk[jj] = 1.f - f;
        vv[jj] = ir;
        run += logf(f);
        cs[jj] = run;
      }
      sGs[tg * 64 + c] = run;
      if (tg == 2) sG16[c] = cs[0];
      __syncthreads();
      {
        float g0 = sGs[c], g1 = sGs[64 + c], g2 = sGs[128 + c], g3 = sGs[192 + c];
        float off = tg == 0 ? 0.f : (tg == 1 ? g0 : (tg == 2 ? g0 + g1 : g0 + g1 + g2));
        float blast = g0 + g1 + g2 + g3;
        float ref = g0 + g1 + sG16[c];
#pragma unroll
        for (int jj = 0; jj < 8; ++jj) {
          int pp = tg * 8 + jj;
          float bj = off + cs[jj];
          sQt[pp * 72 + c] = f2bf(qv[jj] * expf(bj - ref));
          sKt[pp * 72 + c] = f2bf(kk[jj] * expf(ref - bj));
          sQS[pp * 72 + c] = f2bf(qv[jj] * expf(bj));
          sKST[c * 40 + pp] = f2bf(kk[jj] * expf(blast - bj));
          sVT[c * 40 + pp] = f2bf(vv[jj]);
        }
        if (tg == 0) sEB[c] = expf(blast);
      }
      __syncthreads();
      {
        int mt = wave >> 1, nt = wave & 1;
        f32x4 a = f32x4{0.f, 0.f, 0.f, 0.f};
#pragma unroll
        for (int ks = 0; ks < 2; ++ks)
          a = mfma16(ldfrag(sQt + (mt * 16 + l15) * 72 + ks * 32 + q * 8),
                     ldfrag(sKt + (nt * 16 + l15) * 72 + ks * 32 + q * 8), a);
#pragma unroll
        for (int r = 0; r < 4; ++r) {
          int qi = mt * 16 + q * 4 + r, ki = nt * 16 + l15;
          sAtt[qi * 40 + ki] = f2bf(ki <= qi ? a[r] : 0.f);
        }
      }
      __syncthreads();
      {
        int mt = wave & 1, nt0 = (wave >> 1) * 2;
        bf16x8 af = ldfrag(sAtt + (mt * 16 + l15) * 40 + q * 8);
        bf16x8 q0 = ldfrag(sQS + (mt * 16 + l15) * 72 + q * 8), q1 = ldfrag(sQS + (mt * 16 + l15) * 72 + 32 + q * 8);
#pragma unroll
        for (int t2 = 0; t2 < 2; ++t2) {
          int nt = nt0 + t2;
          f32x4 a = f32x4{0.f, 0.f, 0.f, 0.f};
          a = mfma16(af, ldfrag(sVT + (nt * 16 + l15) * 40 + q * 8), a);
          a = mfma16(q0, ldfrag(sST + (nt * 16 + l15) * 72 + q * 8), a);
          a = mfma16(q1, ldfrag(sST + (nt * 16 + l15) * 72 + 32 + q * 8), a);
#pragma unroll
          for (int r = 0; r < 4; ++r) sO[(mt * 16 + q * 4 + r) * 65 + nt * 16 + l15] = a[r];
        }
      }
      __syncthreads();
      {
        bf16x8 af = ldfrag(sKST + (wave * 16 + l15) * 40 + q * 8);
        float eb[4];
#pragma unroll
        for (int r = 0; r < 4; ++r) eb[r] = sEB[wave * 16 + q * 4 + r];
#pragma unroll
        for (int nt = 0; nt < 4; ++nt) {
#pragma unroll
          for (int r = 0; r < 4; ++r) S[nt][r] *= eb[r];
          S[nt] = mfma16(af, ldfrag(sVT + (nt * 16 + l15) * 40 + q * 8), S[nt]);
          uint2 w;
          w.x = pack2(S[nt][0], S[nt][1]);
          w.y = pack2(S[nt][2], S[nt][3]);
          *(uint2*)(sST + (nt * 16 + l15) * 72 + wave * 16 + q * 4) = w;
        }
        int pp = tid >> 3, eg = tid & 7;
        int tok = rev ? n - 1 - (32 * j + pp) : 32 * j + pp;
        size_t row = (size_t)(rowseg + tok);
        bf16_t* dst = p.mix + row * 1024 + 512 + head * 64 + eg * 8;
        float val[8];
#pragma unroll
        for (int k = 0; k < 8; ++k) val[k] = sO[pp * 65 + eg * 8 + k];
        if (!rev) {
          uint4 w;
          w.x = pack2(val[0], val[1]);
          w.y = pack2(val[2], val[3]);
          w.z = pack2(val[4], val[5]);
          w.w = pack2(val[6], val[7]);
          *(uint4*)dst = w;
        } else {
          uint4 of = *(const uint4*)dst;
          unsigned ow[4] = {of.x, of.y, of.z, of.w};
          float ss = 0.f;
#pragma unroll
          for (int k = 0; k < 4; ++k) {
            val[2 * k] += __uint_as_float(ow[k] << 16);
            val[2 * k + 1] += __uint_as_float(ow[k] & 0xffff0000u);
          }
#pragma unroll
          for (int k = 0; k < 8; ++k) ss += val[k] * val[k];
          ss += __shfl_xor(ss, 1);
          ss += __shfl_xor(ss, 2);
          ss += __shfl_xor(ss, 4);
          float rstd = rsqrtf(ss * (1.f / 64.f) + 1e-6f);
          uint4 gq = *(const uint4*)(p.proj + row * LD0 + 3584 + head * 64 + eg * 8);
          unsigned gw[4] = {gq.x, gq.y, gq.z, gq.w};
          float outv[8];
#pragma unroll
          for (int k = 0; k < 4; ++k) {
            float ga = __uint_as_float(gw[k] << 16), gb = __uint_as_float(gw[k] & 0xffff0000u);
            outv[2 * k] = val[2 * k] * rstd * p.hgrn_norm_w[eg * 8 + 2 * k] * siluf(ga);
            outv[2 * k + 1] = val[2 * k + 1] * rstd * p.hgrn_norm_w[eg * 8 + 2 * k + 1] * siluf(gb);
          }
          uint4 w;
          w.x = pack2(outv[0], outv[1]);
          w.y = pack2(outv[2], outv[3]);
          w.z = pack2(outv[4], outv[5]);
          w.w = pack2(outv[6], outv[7]);
          *(uint4*)dst = w;
        }
      }
    }
  }
}

DI void gdn_item(const Params& p, char* smem, int b, int head, int dir, int ehalf) {
  bf16_t* sQ = (bf16_t*)smem;
  bf16_t* sK = sQ + 64 * 136;
  bf16_t* sW = sK + 64 * 136;
  bf16_t* sV = sW + 64 * 136;
  float* sA = (float*)(sV + 64 * 72);
  float* sG = sA + 64 * 64;
  float* sBeta = sG + 64;
  float* sRq = sBeta + 64;
  float* sRk = sRq + 64;
  float* sEg = sRk + 64;
  bf16_t* sKdT = sW;
  bf16_t* sAtt = (bf16_t*)sA;
  const int tid0 = get_tid();
  const bool rev = dir == 1;
  const float neg_a = -expf(p.gdn_a_log[dir * 4 + head]);
  const float dtb = p.gdn_dt_bias[dir * 4 + head];
  bf16_t* gout = (dir == 0 ? p.gdn_of : p.gdn_ob);
  f32x4 S[8];
#pragma unroll
  for (int i = 0; i < 8; ++i) S[i] = f32x4{0.f, 0.f, 0.f, 0.f};
  for (int step = 0; step < 36; ++step) {
    int tid = tid0;
    asm volatile("" : "+v"(tid));
    const int lane = tid & 63, wave = tid >> 6, q = lane >> 4, l15 = lane & 15;
    const bool isctx = step < 4;
    const int n = isctx ? LL : TT;
    const int j = isctx ? step : step - 4;
    const int rowseg = isctx ? NLAT + b * LL : b * TT;
    const int lo = rev ? n - 64 * (j + 1) : 64 * j;
    __syncthreads();
    {
      const int c = tid & 127, th = tid >> 7;
#pragma unroll 1
      for (int tz = 0; tz < 3; ++tz) {
        if (tz == 2 && c >= 64) break;
        const int col = tz == 0 ? head * 128 + c : (tz == 1 ? 512 + head * 128 + c : 1024 + head * 128 + ehalf * 64 + c);
        float w0 = p.gdn_conv_w[col], w1 = p.gdn_conv_w[1536 + col], w2 = p.gdn_conv_w[2 * 1536 + col],
              w3 = p.gdn_conv_w[3 * 1536 + col], w4 = p.gdn_conv_w[4 * 1536 + col];
        const bf16_t* base = p.proj + (size_t)rowseg * LD1 + col;
        const int t0 = lo + th * 32;
        auto raw = [&](int t) -> float { return (t >= 0 && t < n) ? bf2f(base[(size_t)t * LD1]) : 0.f; };
        float x0 = raw(t0 - 2), x1 = raw(t0 - 1), x2 = raw(t0), x3 = raw(t0 + 1);
#pragma unroll 2
        for (int tt = 0; tt < 32; ++tt) {
          float x4 = raw(t0 + tt + 2);
          float y = w0 * x0 + w1 * x1 + w2 * x2 + w3 * x3 + w4 * x4;
          y = siluf(y);
          int tl = th * 32 + tt;
          int pp = rev ? 63 - tl : tl;
          bf16_t yb = f2bf(y);
          if (tz == 0) sQ[pp * 136 + c] = yb;
          else if (tz == 1) sK[pp * 136 + c] = yb;
          else sV[pp * 72 + c] = yb;
          x0 = x1; x1 = x2; x2 = x3; x3 = x4;
        }
      }
      if (tid < 64) {
        int pp = tid;
        int tok = rev ? n - 1 - (64 * j + pp) : 64 * j + pp;
        const bf16_t* pr = p.proj + (size_t)(rowseg + tok) * LD1 + 2816;
        float a = bf2f(pr[dir * 4 + head]), bt = bf2f(pr[8 + dir * 4 + head]);
        float xs = a + dtb;
        float sp = xs > 20.f ? xs : log1pf(expf(xs));
        float g = neg_a * sp;
#pragma unroll
        for (int o = 1; o < 64; o <<= 1) {
          float t = __shfl_up(g, o);
          if (lane >= o) g += t;
        }
        sG[pp] = g;
        sEg[pp] = expf(g);
        sBeta[pp] = sigmoidf_(bt);
      }
    }
    __syncthreads();
    {
      int pp = tid >> 2, part = tid & 3;
      float sq = 0.f, sk = 0.f;
#pragma unroll 8
      for (int k = 0; k < 32; ++k) {
        float a = bf2f(sQ[pp * 136 + part * 32 + k]), bb = bf2f(sK[pp * 136 + part * 32 + k]);
        sq += a * a;
        sk += bb * bb;
      }
      sq += __shfl_xor(sq, 1); sq += __shfl_xor(sq, 2);
      sk += __shfl_xor(sk, 1); sk += __shfl_xor(sk, 2);
      if (part == 0) {
        sRq[pp] = rsqrtf(sq + 1e-6f) * 0.08838834764831845f;
        sRk[pp] = rsqrtf(sk + 1e-6f);
      }
    }
    __syncthreads();
    {
      const int mt = wave;
#pragma unroll
      for (int nt = 0; nt < 4; ++nt) {
        f32x4 a = f32x4{0.f, 0.f, 0.f, 0.f};
        if (nt <= mt) {
#pragma unroll
          for (int ks = 0; ks < 4; ++ks)
            a = mfma16(ldfrag(sK + (mt * 16 + l15) * 136 + ks * 32 + q * 8),
                       ldfrag(sK + (nt * 16 + l15) * 136 + ks * 32 + q * 8), a);
        }
        int jj = nt * 16 + l15;
        float rkj = sRk[jj], gj = sG[jj];
        f32x4 av;
#pragma unroll
        for (int r = 0; r < 4; ++r) {
          int ii = mt * 16 + q * 4 + r;
          float v = 0.f;
          if (ii > jj) v = a[r] * sRk[ii] * rkj * sBeta[ii] * expf(sG[ii] - gj);
          av[r] = v;
        }
        *(f32x4*)(sA + jj * 64 + mt * 16 + q * 4) = av;
      }
    }
    __syncthreads();
    {
      auto solve = [&](auto UP, int cidx) {
        constexpr bool upart = decltype(UP)::value;
        bf16_t* dstb = upart ? sV + cidx : sW + cidx;
        const bf16_t* srcb = upart ? sV + cidx : sK + cidx;
        constexpr int dstr = upart ? 72 : 136;
#pragma unroll 1
        for (int bi = 0; bi < 4; ++bi) {
          float acc[16];
#pragma unroll
          for (int r = 0; r < 16; ++r) {
            int i = bi * 16 + r;
            float rv = bf2f(srcb[i * dstr]) * sBeta[i];
            if (!upart) rv *= sRk[i] * sEg[i];
            acc[r] = rv;
          }
#pragma unroll 2
          for (int j = 0; j < bi * 16; ++j) {
            float sj = bf2f(dstb[j * dstr]);
            const f32x4* ap = (const f32x4*)(sA + j * 64 + bi * 16);
            f32x4 a0 = ap[0], a1 = ap[1], a2 = ap[2], a3 = ap[3];
#pragma unroll
            for (int k = 0; k < 4; ++k) {
              acc[k] -= a0[k] * sj;
              acc[4 + k] -= a1[k] * sj;
              acc[8 + k] -= a2[k] * sj;
              acc[12 + k] -= a3[k] * sj;
            }
          }
          const float* ab = sA + (bi * 16) * 64 + bi * 16;
#pragma unroll
          for (int r = 0; r < 16; ++r) {
            float sr = acc[r];
            dstb[(bi * 16 + r) * dstr] = f2bf(sr);
#pragma unroll
            for (int r2 = r + 1; r2 < 16; ++r2) acc[r2] -= ab[r * 64 + r2] * sr;
            __builtin_amdgcn_sched_barrier(0);
          }
        }
      };
      if (tid < 64) solve(std::true_type{}, tid);
      else if (tid < 192) solve(std::false_type{}, tid - 64);
    }
    __syncthreads();
    f32x4 vn[4], oo[4];
    {
      bf16x8 sf[4];
#pragma unroll
      for (int ks = 0; ks < 4; ++ks) sf[ks] = packfrag(S[2 * ks], S[2 * ks + 1]);
#pragma unroll
      for (int mt = 0; mt < 4; ++mt) {
        f32x4 ws = f32x4{0.f, 0.f, 0.f, 0.f}, qs = f32x4{0.f, 0.f, 0.f, 0.f};
#pragma unroll
        for (int ks = 0; ks < 4; ++ks) {
          ws = mfma16(ldfrag_perm(sW + (mt * 16 + l15) * 136, ks, q), sf[ks], ws);
          qs = mfma16(ldfrag_perm(sQ + (mt * 16 + l15) * 136, ks, q), sf[ks], qs);
        }
#pragma unroll
        for (int r = 0; r < 4; ++r) {
          int ii = mt * 16 + q * 4 + r;
          vn[mt][r] = bf2f(sV[ii * 72 + wave * 16 + l15]) - ws[r];
          oo[mt][r] = qs[r] * sRq[ii] * sEg[ii];
        }
        __builtin_amdgcn_sched_barrier(0);
      }
    }
    __syncthreads();
    {
      const int d = tid & 127, hf = tid >> 7;
      const float glast = sG[63];
#pragma unroll 4
      for (int jj = 0; jj < 32; ++jj) {
        int jt = hf * 32 + jj;
        sKdT[d * 68 + jt] = f2bf(bf2f(sK[jt * 136 + d]) * sRk[jt] * expf(glast - sG[jt]));
      }
      const int mt = wave;
      f32x4 a[4];
#pragma unroll
      for (int nt = 0; nt < 4; ++nt) {
        a[nt] = f32x4{0.f, 0.f, 0.f, 0.f};
        if (nt <= mt) {
#pragma unroll
          for (int ks = 0; ks < 4; ++ks)
            a[nt] = mfma16(ldfrag(sQ + (mt * 16 + l15) * 136 + ks * 32 + q * 8),
                           ldfrag(sK + (nt * 16 + l15) * 136 + ks * 32 + q * 8), a[nt]);
        }
      }
#pragma unroll
      for (int nt = 0; nt < 4; ++nt) {
        int jj = nt * 16 + l15;
        float rkj = sRk[jj], gj = sG[jj];
#pragma unroll
        for (int r = 0; r < 4; ++r) {
          int ii = mt * 16 + q * 4 + r;
          float v = 0.f;
          if (ii >= jj) v = a[nt][r] * sRq[ii] * rkj * expf(sG[ii] - gj);
          sAtt[ii * 72 + jj] = f2bf(v);
        }
      }
    }
    __syncthreads();
    {
      bf16x8 vf[2];
      vf[0] = packfrag(vn[0], vn[1]);
      vf[1] = packfrag(vn[2], vn[3]);
#pragma unroll
      for (int mt = 0; mt < 4; ++mt)
#pragma unroll
        for (int ks = 0; ks < 2; ++ks) oo[mt] = mfma16(ldfrag_perm(sAtt + (mt * 16 + l15) * 72, ks, q), vf[ks], oo[mt]);
      __builtin_amdgcn_sched_barrier(0);
      if (!isctx) {
        bf16_t* gb = gout + (size_t)(b * TT) * 512 + head * 128 + ehalf * 64;
        const int tok0 = rev ? n - 1 - (64 * j + q * 4) : 64 * j + q * 4;
        const int tstep = rev ? -512 : 512;
        unsigned off0 = (unsigned)(tok0 * 512 + wave * 16 + l15);
#pragma unroll
        for (int mt = 0; mt < 4; ++mt)
#pragma unroll
          for (int r = 0; r < 4; ++r) {
            unsigned off = off0 + (unsigned)((mt * 16 + r) * tstep);
            gb[off] = f2bf(oo[mt][r]);
          }
      }
      __builtin_amdgcn_sched_barrier(0);
      const float egl = sEg[63];
#pragma unroll
      for (int m8 = 0; m8 < 8; ++m8) {
#pragma unroll
        for (int r = 0; r < 4; ++r) S[m8][r] *= egl;
#pragma unroll
        for (int ks = 0; ks < 2; ++ks) S[m8] = mfma16(ldfrag_perm(sKdT + (m8 * 16 + l15) * 68, ks, q), vf[ks], S[m8]);
        __builtin_amdgcn_sched_barrier(0);
      }
    }
  }
}

DI void phase_gdn_finalize(const Params& p) {
  const int tid = get_tid();
  const int gid = blockIdx.x * NTHREADS + tid;
  const int nth = gridDim.x * NTHREADS;
  const int l32 = tid & 31;
  for (int w = gid >> 5; w < NLAT * 4; w += nth >> 5) {
    int tok = w >> 2, head = w & 3;
    size_t off = (size_t)tok * 512 + head * 128 + l32 * 4;
    uint2 a = *(const uint2*)(p.gdn_of + off), bq = *(const uint2*)(p.gdn_ob + off);
    float v[4];
    v[0] = __uint_as_float(a.x << 16) + __uint_as_float(bq.x << 16);
    v[1] = __uint_as_float(a.x & 0xffff0000u) + __uint_as_float(bq.x & 0xffff0000u);
    v[2] = __uint_as_float(a.y << 16) + __uint_as_float(bq.y << 16);
    v[3] = __uint_as_float(a.y & 0xffff0000u) + __uint_as_float(bq.y & 0xffff0000u);
    float ss = v[0] * v[0] + v[1] * v[1] + v[2] * v[2] + v[3] * v[3];
#pragma unroll
    for (int o = 16; o >= 1; o >>= 1) ss += __shfl_xor(ss, o);
    float rstd = rsqrtf(ss * (1.f / 128.f) + 1e-6f);
    uint2 zq = *(const uint2*)(p.proj + (size_t)tok * LD1 + 1536 + head * 128 + l32 * 4);
    float z[4] = {__uint_as_float(zq.x << 16), __uint_as_float(zq.x & 0xffff0000u), __uint_as_float(zq.y << 16),
                  __uint_as_float(zq.y & 0xffff0000u)};
    float4 nw = *(const float4*)(p.gdn_norm_w + l32 * 4);
    uint2 o;
    o.x = pack2(v[0] * rstd * nw.x * siluf(z[0]), v[1] * rstd * nw.y * siluf(z[1]));
    o.y = pack2(v[2] * rstd * nw.z * siluf(z[2]), v[3] * rstd * nw.w * siluf(z[3]));
    *(uint2*)(p.mix + (size_t)tok * 1024 + head * 128 + l32 * 4) = o;
  }
}

DI int next_item(unsigned* counter, int* sslot) {
  __syncthreads();
  if (get_tid() == 0) *sslot = (int)atomicAdd(counter, 1u);
  __syncthreads();
  return *sslot;
}

DI void phase_mixer0(const Params& p, char* smem) {
  int* sslot = (int*)(smem + SMEM_BYTES - 16);
  float lam;
  {
    float s1 = 0.f, s2 = 0.f;
    for (int i = 0; i < 64; ++i) {
      s1 += p.diff_lambda[i] * p.diff_lambda[64 + i];
      s2 += p.diff_lambda[128 + i] * p.diff_lambda[192 + i];
    }
    lam = expf(s1) - expf(s2) + 0.2f;
  }
  const int NH = 256, NDL = NB * 4 * 32, NDC = NB * 4 * 4;
  while (true) {
    int item = next_item(p.counters + 0, sslot);
    if (item >= NH + NDL + NDC) break;
    if (item < NH) {
      hgrn_item(p, smem, item >> 3, item & 7);
    } else if (item < NH + NDL) {
      int i = item - NH;
      diff_item(p, smem, i >> 7, (i >> 5) & 3, i & 31, false, lam);
    } else {
      int i = item - NH - NDL;
      diff_item(p, smem, i >> 4, (i >> 2) & 3, i & 3, true, lam);
    }
  }
}

DI void phase_mixer1(const Params& p, char* smem) {
  int* sslot = (int*)(smem + SMEM_BYTES - 16);
  const int NG = 512, NS = NB * 8 * 32;
  while (true) {
    int item = next_item(p.counters + 1, sslot);
    if (item >= NG + NS) break;
    if (item < NG) {
      gdn_item(p, smem, item >> 4, (item >> 2) & 3, (item >> 1) & 1, item & 1);
    } else {
      int i = item - NG;
      swa_item(p, smem, i >> 8, (i >> 5) & 7, i & 31);
    }
  }
}

DI void phase_topk(const Params& p, char* smem, int layer, int ntok) {
  float* sS = (float*)smem;
  float* sTV = sS + 2 * 64 * 129;
  unsigned char* sTI = (unsigned char*)(sTV + 2 * 16 * 64);
  float* sSelV = sS;
  int* sSelC = (int*)(sS + 16 * 64);
  const int tid0 = get_tid();
  const bf16_t* keys = p.keys_bf + (size_t)layer * 8 * 2 * 128 * 128;
  for (int item = blockIdx.x; item < ntok / 64; item += gridDim.x) {
    const int tok0 = item * 64;
    for (int h = 0; h < 8; ++h) {
      int tid = tid0;
      asm volatile("" : "+v"(tid));
      const int lane = tid & 63, wave = tid >> 6, q = lane >> 4, l15 = lane & 15;
      __syncthreads();
#pragma unroll
      for (int pp = 0; pp < 2; ++pp) {
        f32x4 acc[8];
#pragma unroll
        for (int nt = 0; nt < 8; ++nt) acc[nt] = f32x4{0.f, 0.f, 0.f, 0.f};
        const bf16_t* kb = keys + (size_t)(h * 2 + pp) * 128 * 128;
#pragma unroll
        for (int ks = 0; ks < 4; ++ks) {
          bf16x8 a = *(const bf16x8*)(p.pq + (size_t)(tok0 + wave * 16 + l15) * 2048 + h * 256 + pp * 128 + ks * 32 + q * 8);
#pragma unroll
          for (int nt = 0; nt < 8; ++nt) {
            bf16x8 bb = *(const bf16x8*)(kb + (nt * 16 + l15) * 128 + ks * 32 + q * 8);
            acc[nt] = mfma16(a, bb, acc[nt]);
          }
        }
#pragma unroll
        for (int nt = 0; nt < 8; ++nt)
#pragma unroll
          for (int r = 0; r < 4; ++r) sS[(pp * 64 + wave * 16 + q * 4 + r) * 129 + nt * 16 + l15] = acc[nt][r];
      }
      __syncthreads();
      {
        const int rowid = tid >> 1, half = tid & 1;
        const int pp = rowid >> 6, t = rowid & 63;
        const float* row = sS + (size_t)rowid * 129 + half * 64;
        float prev_v = INFINITY;
        int prev_i = -1;
        for (int r = 0; r < 16; ++r) {
          float best_v = -INFINITY;
          int best_i = 1 << 30;
#pragma unroll 8
          for (int kk = 0; kk < 64; ++kk) {
            int ko = (kk + half * 16) & 63;
            float v = row[ko];
            int k = half * 64 + ko;
            bool elig = (v < prev_v) || (v == prev_v && k > prev_i);
            bool better = (v > best_v) || (v == best_v && k < best_i);
            if (elig && better) {
              best_v = v;
              best_i = k;
            }
          }
          float ov = __shfl_xor(best_v, 1);
          int oi = __shfl_xor(best_i, 1);
          if (ov > best_v || (ov == best_v && oi < best_i)) {
            best_v = ov;
            best_i = oi;
          }
          prev_v = best_v;
          prev_i = best_i;
          if (half == 0) {
            sTV[(pp * 16 + r) * 64 + t] = best_v;
            sTI[(pp * 16 + r) * 64 + t] = (unsigned char)best_i;
          }
        }
      }
      __syncthreads();
      if (tid < 64) {
        const int t = tid;
        float s1[16], s2[16];
#pragma unroll
        for (int i = 0; i < 16; ++i) {
          s1[i] = sTV[i * 64 + t];
          s2[i] = sTV[(16 + i) * 64 + t];
        }
        float prev_v = INFINITY;
        int prev_c = -1;
        float mx = 0.f, sum = 0.f;
        for (int r = 0; r < 16; ++r) {
          float best_v = -INFINITY;
          int best_c = 1 << 30;
#pragma unroll
          for (int i = 0; i < 16; ++i)
#pragma unroll
            for (int jx = 0; jx < 16; ++jx) {
              if ((i + 1) * (jx + 1) <= 16) {
                float v = s1[i] + s2[jx];
                int ci = i * 16 + jx;
                bool elig = (v < prev_v) || (v == prev_v && ci > prev_c);
                bool better = (v > best_v) || (v == best_v && ci < best_c);
                if (elig && better) {
                  best_v = v;
                  best_c = ci;
                }
              }
            }
          prev_v = best_v;
          prev_c = best_c;
          if (r == 0) mx = best_v;
          sum += expf(best_v - mx);
          sSelV[r * 64 + t] = best_v;
          sSelC[r * 64 + t] = best_c;
        }
        float inv = 1.f / sum;
        for (int r = 0; r < 16; ++r) {
          float v = sSelV[r * 64 + t];
          int ci = sSelC[r * 64 + t];
          int i1 = sTI[((ci >> 4)) * 64 + t], i2 = sTI[(16 + (ci & 15)) * 64 + t];
          size_t o = (size_t)(tok0 + t) * 128 + h * 16 + r;
          p.pidx[o] = i1 * 128 + i2;
          p.pgate[o] = expf(v - mx) * inv;
        }
      }
    }
  }
}

DI void phase_experts(const Params& p, int layer, int ntok) {
  const int lane = get_tid() & 63, wave = get_tid() >> 6;
  const bf16_t* ub = p.u_bf + (size_t)layer * 16384 * 1024;
  const bf16_t* vb = p.v_bf + (size_t)layer * 16384 * 1024;
  for (int tok = blockIdx.x * 4 + wave; tok < ntok; tok += gridDim.x * 4) {
    const bf16_t* hrow = p.mix + (size_t)tok * 1024;
    uint4 xa = *(const uint4*)(hrow + lane * 8), xb = *(const uint4*)(hrow + 512 + lane * 8);
    unsigned xw[8] = {xa.x, xa.y, xa.z, xa.w, xb.x, xb.y, xb.z, xb.w};
    int i0 = p.pidx[(size_t)tok * 128 + lane], i1 = p.pidx[(size_t)tok * 128 + 64 + lane];
    float g0 = p.pgate[(size_t)tok * 128 + lane], g1 = p.pgate[(size_t)tok * 128 + 64 + lane];
    float acc[16];
#pragma unroll
    for (int k = 0; k < 16; ++k) acc[k] = 0.f;
    for (int e = 0; e < 128; e += 4) {
      int rows[4];
      float gates[4];
#pragma unroll
      for (int u = 0; u < 4; ++u) {
        int ee = e + u;
        rows[u] = __shfl(ee < 64 ? i0 : i1, ee & 63);
        gates[u] = __shfl(ee < 64 ? g0 : g1, ee & 63);
      }
      u32x4 ua[4], ub2[4];
#pragma unroll
      for (int u = 0; u < 4; ++u) {
        const bf16_t* ur = ub + (size_t)rows[u] * 1024;
        ua[u] = *(const u32x4*)(ur + lane * 8);
        ub2[u] = *(const u32x4*)(ur + 512 + lane * 8);
      }
      float d[4];
#pragma unroll
      for (int u = 0; u < 4; ++u) {
        unsigned uw[8] = {ua[u][0], ua[u][1], ua[u][2], ua[u][3], ub2[u][0], ub2[u][1], ub2[u][2], ub2[u][3]};
        float s = 0.f;
#pragma unroll
        for (int k = 0; k < 8; ++k)
          s = __builtin_amdgcn_fdot2_f32_bf16(__builtin_bit_cast(bf2_t, xw[k]), __builtin_bit_cast(bf2_t, uw[k]), s, false);
        d[u] = s;
      }
#pragma unroll
      for (int o = 32; o >= 1; o >>= 1) {
#pragma unroll
        for (int u = 0; u < 4; ++u) d[u] += __shfl_xor(d[u], o);
      }
      u32x4 va[4], vb2[4];
#pragma unroll
      for (int u = 0; u < 4; ++u) {
        const bf16_t* vr = vb + (size_t)rows[u] * 1024;
        va[u] = *(const u32x4*)(vr + lane * 8);
        vb2[u] = *(const u32x4*)(vr + 512 + lane * 8);
      }
#pragma unroll
      for (int u = 0; u < 4; ++u) {
        float xd = d[u];
        float coef = gates[u] * 0.5f * xd * (1.f + erff(xd * 0.7071067811865476f));
        unsigned vw[8] = {va[u][0], va[u][1], va[u][2], va[u][3], vb2[u][0], vb2[u][1], vb2[u][2], vb2[u][3]};
#pragma unroll
        for (int k = 0; k < 8; ++k) {
          acc[2 * k] += coef * __uint_as_float(vw[k] << 16);
          acc[2 * k + 1] += coef * __uint_as_float(vw[k] & 0xffff0000u);
        }
      }
    }
    int vec = vec_of_row(tok);
    float* xr = tok < NLAT ? p.out + (size_t)tok * 1024 : p.xc + (size_t)(tok - NLAT) * 1024;
    const float* g2 = modp(p, layer, vec, 5);
    float xn[16];
    float ss = 0.f;
#pragma unroll
    for (int hlf = 0; hlf < 2; ++hlf) {
      int c0 = hlf * 512 + lane * 8;
      float4 a = *(const float4*)(xr + c0), bq = *(const float4*)(xr + c0 + 4);
      float4 ga = *(const float4*)(g2 + c0), gb = *(const float4*)(g2 + c0 + 4);
      float* o = xn + hlf * 8;
      o[0] = a.x + ga.x * acc[hlf * 8 + 0];
      o[1] = a.y + ga.y * acc[hlf * 8 + 1];
      o[2] = a.z + ga.z * acc[hlf * 8 + 2];
      o[3] = a.w + ga.w * acc[hlf * 8 + 3];
      o[4] = bq.x + gb.x * acc[hlf * 8 + 4];
      o[5] = bq.y + gb.y * acc[hlf * 8 + 5];
      o[6] = bq.z + gb.z * acc[hlf * 8 + 6];
      o[7] = bq.w + gb.w * acc[hlf * 8 + 7];
#pragma unroll
      for (int k = 0; k < 8; ++k) ss += o[k] * o[k];
    }
    ss = wave_sum(ss);
    float rstd = rsqrtf(ss * (1.f / 1024.f) + 1e-6f);
    if (layer == 0) {
      const float* nw = p.norm_w + (1 * 2 + 0) * 1024;
      const float* sh = modp(p, 1, vec, 0);
      const float* sc = modp(p, 1, vec, 1);
#pragma unroll
      for (int hlf = 0; hlf < 2; ++hlf) {
        int c0 = hlf * 512 + lane * 8;
        float* o = xn + hlf * 8;
        *(float4*)(xr + c0) = float4{o[0], o[1], o[2], o[3]};
        *(float4*)(xr + c0 + 4) = float4{o[4], o[5], o[6], o[7]};
        float hv[8];
#pragma unroll
        for (int k = 0; k < 8; ++k) hv[k] = o[k] * rstd * nw[c0 + k] * (1.f + sc[c0 + k]) + sh[c0 + k];
        uint4 w;
        w.x = pack2(hv[0], hv[1]);
        w.y = pack2(hv[2], hv[3]);
        w.z = pack2(hv[4], hv[5]);
        w.w = pack2(hv[6], hv[7]);
        *(uint4*)(p.mix + (size_t)tok * 1024 + c0) = w;
      }
    } else {
      const float* fw = p.final_norm_w;
#pragma unroll
      for (int hlf = 0; hlf < 2; ++hlf) {
        int c0 = hlf * 512 + lane * 8;
        float* o = xn + hlf * 8;
        float4 w0 = *(const float4*)(fw + c0), w1 = *(const float4*)(fw + c0 + 4);
        *(float4*)(xr + c0) = float4{o[0] * rstd * w0.x, o[1] * rstd * w0.y, o[2] * rstd * w0.z, o[3] * rstd * w0.w};
        *(float4*)(xr + c0 + 4) = float4{o[4] * rstd * w1.x, o[5] * rstd * w1.y, o[6] * rstd * w1.z, o[7] * rstd * w1.w};
      }
    }
  }
}

DI void run_phase(const Params& p, int ph, char* smem) {
  switch (ph) {
    case 0: phase_setup(p, smem); break;
    case 1: phase_modulate(p, p.x, p.ctx, NTOK, 0, 0); break;
    case 2: phase_gemm<EPI_IN0>(p, p.mix, p.wt_in0, NTOK, 4096, smem, 0, nullptr, nullptr); break;
    case 3: phase_mixer0(p, smem); break;
    case 4: phase_gemm<EPI_OUT>(p, p.mix, p.wt_out0, NTOK, 1024, smem, 0, p.x, p.ctx); break;
    case 5: phase_modulate(p, p.out, p.xc, NTOK, 0, 1); break;
    case 6: phase_gemm<EPI_PQ>(p, p.mix, p.wt_q, NTOK, 2048, smem, 0, nullptr, nullptr); break;
    case 7: phase_topk(p, smem, 0, NTOK); break;
    case 8: phase_experts(p, 0, NTOK); break;
    case 9: phase_gemm<EPI_IN1>(p, p.mix, p.wt_in1, NTOK, 2944, smem, 1, nullptr, nullptr); break;
    case 10: phase_mixer1(p, smem); break;
    case 11: phase_gdn_finalize(p); break;
    case 12: phase_gemm<EPI_OUT>(p, p.mix, p.wt_out1, NLAT, 1024, smem, 1, p.out, p.xc); break;
    case 13: phase_modulate(p, p.out, p.xc, NLAT, 1, 1); break;
    case 14: phase_gemm<EPI_PQ>(p, p.mix, p.wt_q + (size_t)2048 * 1024, NLAT, 2048, smem, 1, nullptr, nullptr); break;
    case 15: phase_topk(p, smem, 1, NLAT); break;
    case 16: phase_experts(p, 1, NLAT); break;
  }
}

#if SINGLE_LAUNCH
__global__ void __launch_bounds__(NTHREADS, 1) mega_kernel(Params p, int ph_lo, int ph_hi) {
  __shared__ __attribute__((aligned(16))) char smem[SMEM_BYTES];
  for (int ph = ph_lo; ph < ph_hi; ++ph) {
    if (ph > ph_lo) cg::this_grid().sync();
    run_phase(p, ph, smem);
  }
}
#define OCC_KERNEL mega_kernel
#else
template <int PH>
__global__ void __launch_bounds__(NTHREADS, (PH == 10 ? 1 : 2)) phase_kernel(Params p) {
  __shared__ __attribute__((aligned(16))) char smem[SMEM_BYTES];
  run_phase(p, PH, smem);
}
#define OCC_KERNEL phase_kernel<3>
template <int PH>
static void launch_phases(const Params& p, int grid, hipStream_t stream) {
  hipLaunchKernelGGL(phase_kernel<PH>, dim3(grid), dim3(NTHREADS), 0, stream, p);
  if constexpr (PH + 1 < NPHASES) launch_phases<PH + 1>(p, grid, stream);
}
#endif

extern "C" void kernel_launch(void* const* d_in, const int* in_sizes, int n_in, void* d_out, int out_size, void* d_ws,
                              size_t ws_size, hipStream_t stream) {
  static int grid_blocks = 0;
  if (!grid_blocks) {
    int dev = 0, cus = 0, per_cu = 0;
    (void)hipGetDevice(&dev);
    (void)hipDeviceGetAttribute(&cus, hipDeviceAttributeMultiprocessorCount, dev);
    (void)hipOccupancyMaxActiveBlocksPerMultiprocessor(&per_cu, OCC_KERNEL, NTHREADS, 0);
    if (per_cu < 1) per_cu = 1;
    if (per_cu > 2) per_cu = 2;
    grid_blocks = cus * per_cu;
  }
  Params p{};
  const float** fp = (const float**)&p;
  for (int i = 0; i < 25; ++i) fp[i] = (const float*)d_in[i];
  p.out = (float*)d_out;
  char* ws = (char*)d_ws;
  size_t off = 0;
  auto take = [&](size_t bytes) { char* r = ws + off; off += (bytes + 255) & ~(size_t)255; return r; };
  p.proj = (bf16_t*)take((size_t)NTOK * LD0 * 2);
  p.mix = (bf16_t*)take((size_t)NTOK * 1024 * 2);
  p.xc = (float*)take((size_t)NCTX * 1024 * 4);
  p.mod = (float*)take((size_t)2 * 33 * 6144 * 4);
  p.rope = (float*)take(64 * 16 * 2 * 4);
  p.wt_in0 = (bf16_t*)take((size_t)4096 * 1024 * 2);
  p.wt_out0 = (bf16_t*)take((size_t)1024 * 1024 * 2);
  p.wt_in1 = (bf16_t*)take((size_t)2944 * 1024 * 2);
  p.wt_out1 = (bf16_t*)take((size_t)1024 * 1024 * 2);
  p.wt_q = (bf16_t*)take((size_t)2 * 2048 * 1024 * 2);
  p.keys_bf = (bf16_t*)take((size_t)2 * 8 * 2 * 128 * 128 * 2);
  p.u_bf = (bf16_t*)take((size_t)2 * 16384 * 1024 * 2);
  p.v_bf = (bf16_t*)take((size_t)2 * 16384 * 1024 * 2);
  p.counters = (unsigned*)take(256);
  p.pq = p.proj;
  p.pidx = (int*)((char*)p.proj + (size_t)NTOK * 2048 * 2);
  p.pgate = (float*)((char*)p.pidx + (size_t)NTOK * 128 * 4);
  p.gdn_of = (bf16_t*)((char*)p.proj + (size_t)NTOK * LD1 * 2);
  p.gdn_ob = p.gdn_of + (size_t)NLAT * 512;
  if (off > ws_size) fprintf(stderr, "workspace too small: need %zu have %zu\n", off, ws_size);
#if SINGLE_LAUNCH
  int lo = 0, hi = NPHASES;
  void* args[] = {&p, &lo, &hi};
  hipError_t e = hipLaunchCooperativeKernel((void*)mega_kernel, dim3(grid_blocks), dim3(NTHREADS), args, 0, stream);
  if (e != hipSuccess) fprintf(stderr, "cooperative launch failed: %s (grid %d)\n", hipGetErrorString(e), grid_blocks);
#else
  launch_phases<0>(p, grid_blocks, stream);
#endif
}
```

```cpp
#include <hip/hip_runtime.h>
#include <hip/hip_cooperative_groups.h>
#include <cstdio>
#include <type_traits>
namespace cg = cooperative_groups;

#ifndef SINGLE_LAUNCH
#define SINGLE_LAUNCH 1
#endif

typedef unsigned short bf16_t;
using bf16x8 = __attribute__((ext_vector_type(8))) short;
using s16x4 = __attribute__((ext_vector_type(4))) short;
using f32x4 = __attribute__((ext_vector_type(4))) float;
using u32x4 = __attribute__((ext_vector_type(4))) unsigned;
typedef __attribute__((ext_vector_type(2))) __bf16 bf2_t;
#define DI __device__ __forceinline__

constexpr int NB = 32, TT = 2048, LL = 256, DM = 1024;
constexpr int NLAT = NB * TT, NCTX = NB * LL, NTOK = NLAT + NCTX;
constexpr int LD0 = 4096, LD1 = 2944;
constexpr int SMEM_BYTES = 79360;
constexpr int NTHREADS = 256;
constexpr int NPHASES = 19;

struct Params {
  const float *x, *c, *ctx, *c_ctx, *ada_w, *ada_b, *norm_w, *final_norm_w, *even_w_in, *even_w_out, *diff_lambda,
      *diff_subln_w, *hgrn_lb, *hgrn_norm_w, *odd_w_in, *odd_w_out, *gdn_conv_w, *gdn_a_log, *gdn_dt_bias, *gdn_norm_w,
      *swa_sink, *peer_w_q, *peer_keys, *peer_u, *peer_v;
  float* out;
  bf16_t *proj, *mix, *wt_in0, *wt_out0, *wt_in1, *wt_out1, *wt_q, *keys_bf, *gdn_of, *gdn_ob;
  float* pq;
  unsigned char *u_q, *v_q;
  float *u_sc, *v_sc;
  float *xc, *mod, *rope, *pgate;
  int* pidx;
  unsigned* counters;
};

DI int get_tid() {
  int t = threadIdx.x;
  asm volatile("" : "+v"(t));
  return t;
}
DI bf16_t f2bf(float x) { return __builtin_bit_cast(unsigned short, (__bf16)x); }
DI float bf2f(bf16_t h) { return __uint_as_float(((unsigned)h) << 16); }
DI unsigned pack2(float a, float b) {
  typedef __attribute__((ext_vector_type(2))) float f32x2_t;
  f32x2_t v = {a, b};
  return __builtin_bit_cast(unsigned, __builtin_convertvector(v, bf2_t));
}
DI f32x4 mfma16(bf16x8 a, bf16x8 b, f32x4 c) { return __builtin_amdgcn_mfma_f32_16x16x32_bf16(a, b, c, 0, 0, 0); }
DI bf16x8 ldfrag(const bf16_t* p) { return *(const bf16x8*)p; }
DI bf16x8 ldfrag_perm(const bf16_t* row, int ks, int q) {
  s16x4 lo = *(const s16x4*)(row + ks * 32 + q * 4);
  s16x4 hi = *(const s16x4*)(row + ks * 32 + 16 + q * 4);
  return __builtin_shufflevector(lo, hi, 0, 1, 2, 3, 4, 5, 6, 7);
}
DI bf16x8 packfrag(f32x4 a, f32x4 b) {
  unsigned w0 = pack2(a[0], a[1]), w1 = pack2(a[2], a[3]), w2 = pack2(b[0], b[1]), w3 = pack2(b[2], b[3]);
  typedef __attribute__((ext_vector_type(4))) unsigned u32x4;
  u32x4 v = {w0, w1, w2, w3};
  return __builtin_bit_cast(bf16x8, v);
}
DI float siluf(float x) { return x / (1.f + expf(-x)); }
DI float silu_fast(float x) { return __fdividef(x, 1.f + __expf(-x)); }
DI float sigmoidf_(float x) { return 1.f / (1.f + expf(-x)); }
template <int N>
DI float dpp_ror(float v) {
  return __builtin_bit_cast(float, __builtin_amdgcn_update_dpp(0, __builtin_bit_cast(int, v), 0x120 + N, 0xf, 0xf, false));
}
DI float grp16_sum(float v) {
  v += dpp_ror<8>(v);
  v += dpp_ror<4>(v);
  v += dpp_ror<2>(v);
  v += dpp_ror<1>(v);
  return v;
}
DI float grp16_max(float v) {
  v = fmaxf(v, dpp_ror<8>(v));
  v = fmaxf(v, dpp_ror<4>(v));
  v = fmaxf(v, dpp_ror<2>(v));
  v = fmaxf(v, dpp_ror<1>(v));
  return v;
}
DI float rows_sum(float v) {
  auto a = __builtin_amdgcn_permlane16_swap(__float_as_uint(v), __float_as_uint(v), false, false);
  v = __uint_as_float(a[0]) + __uint_as_float(a[1]);
  auto b = __builtin_amdgcn_permlane32_swap(__float_as_uint(v), __float_as_uint(v), false, false);
  return __uint_as_float(b[0]) + __uint_as_float(b[1]);
}
DI float rows_max(float v) {
  auto a = __builtin_amdgcn_permlane16_swap(__float_as_uint(v), __float_as_uint(v), false, false);
  v = fmaxf(__uint_as_float(a[0]), __uint_as_float(a[1]));
  auto b = __builtin_amdgcn_permlane32_swap(__float_as_uint(v), __float_as_uint(v), false, false);
  return fmaxf(__uint_as_float(b[0]), __uint_as_float(b[1]));
}
DI float rows_min(float v) {
  auto a = __builtin_amdgcn_permlane16_swap(__float_as_uint(v), __float_as_uint(v), false, false);
  v = fminf(__uint_as_float(a[0]), __uint_as_float(a[1]));
  auto b = __builtin_amdgcn_permlane32_swap(__float_as_uint(v), __float_as_uint(v), false, false);
  return fminf(__uint_as_float(b[0]), __uint_as_float(b[1]));
}
DI int rows_sum_i(int v) {
  auto a = __builtin_amdgcn_permlane16_swap((unsigned)v, (unsigned)v, false, false);
  v = (int)(a[0] + a[1]);
  auto b = __builtin_amdgcn_permlane32_swap((unsigned)v, (unsigned)v, false, false);
  return (int)(b[0] + b[1]);
}
DI float wave_sum(float v) { return rows_sum(grp16_sum(v)); }
DI const float* modp(const Params& p, int layer, int vec, int chunk) {
  return p.mod + ((size_t)(layer * 33 + vec) * 6 + chunk) * 1024;
}
DI int vec_of_row(int row) { return row < NLAT ? (row >> 11) : 32; }

DI void transpose_job(const float* W, int nsrc, bf16_t* Wt, int n0, int k0, int mapmode, float* tile) {
  const int tid = get_tid();
  __syncthreads();
#pragma unroll 4
  for (int i = 0; i < 16; ++i) {
    int kk = (tid >> 6) + 4 * i, nn = tid & 63;
    int nd = n0 + nn, ns = nd;
    if (mapmode == 1) ns = nd < 2048 ? nd : (nd < 2816 ? nd + 16 : (nd < 2832 ? nd - 768 : -1));
    float v = ns >= 0 ? W[(size_t)(k0 + kk) * nsrc + ns] : 0.f;
    tile[kk * 65 + nn] = v;
  }
  __syncthreads();
#pragma unroll 4
  for (int i = 0; i < 16; ++i) {
    int nn = (tid >> 6) + 4 * i, kk = tid & 63;
    Wt[(size_t)(n0 + nn) * 1024 + k0 + kk] = f2bf(tile[kk * 65 + nn]);
  }
}

DI void convert_seg(const float* src, bf16_t* dst, size_t n4) {
  size_t stride = (size_t)gridDim.x * NTHREADS;
  for (size_t i = (size_t)blockIdx.x * NTHREADS + get_tid(); i < n4; i += stride) {
    float4 v = ((const float4*)src)[i];
    uint2 o;
    o.x = pack2(v.x, v.y);
    o.y = pack2(v.z, v.w);
    ((uint2*)dst)[i] = o;
  }
}

DI int setup_next_item(unsigned* counter, int* sslot) {
  __syncthreads();
  if (get_tid() == 0) *sslot = (int)atomicAdd(counter, 1u);
  __syncthreads();
  return *sslot;
}

DI void phase_setup(const Params& p, char* smem) {
  const int tid = get_tid();
  float* sm = (float*)smem;
  int* sslot = (int*)(smem + SMEM_BYTES - 16);
  for (int i = blockIdx.x * NTHREADS + tid; i < 64 * 16; i += gridDim.x * NTHREADS) {
    int pos = i >> 4, f = i & 15;
    float inv = powf(10000.f, -(float)f / 16.f);
    float ang = (float)pos * inv;
    p.rope[i * 2] = cosf(ang);
    p.rope[i * 2 + 1] = sinf(ang);
  }
  const int NA = 384, J0 = 1024, J1 = J0 + 256, J2 = J1 + 736, J3 = J2 + 256, J4 = J3 + 512, NQI = 2048;
  while (true) {
    const int item = setup_next_item(p.counters + 8, sslot);
    if (item >= NA + J4 + NQI) break;
    if (item < NA) {
      const int job = item;
      const int layer = job / 192, col0 = (job % 192) * 32;
      float acc[33];
#pragma unroll
      for (int v = 0; v < 33; ++v) acc[v] = 0.f;
      float* sc = sm;
      float* red = sm + 33 * 256;
      const int col = col0 + (tid & 31), kq = tid >> 5;
      for (int kc = 0; kc < 4; ++kc) {
        __syncthreads();
        for (int idx = tid; idx < 33 * 256; idx += NTHREADS) {
          int v = idx >> 8, kk = idx & 255, k = kc * 256 + kk;
          float cv = v < 32 ? p.c[v * 1024 + k] : p.c_ctx[k];
          sc[idx] = siluf(cv);
        }
        __syncthreads();
#pragma unroll 8
        for (int kk = kq * 32; kk < kq * 32 + 32; ++kk) {
          float w = p.ada_w[((size_t)layer * 1024 + kc * 256 + kk) * 6144 + col];
#pragma unroll
          for (int v = 0; v < 33; ++v) acc[v] += sc[v * 256 + kk] * w;
        }
      }
      __syncthreads();
#pragma unroll
      for (int v = 0; v < 33; ++v) red[(kq * 33 + v) * 32 + (tid & 31)] = acc[v];
      __syncthreads();
      for (int idx = tid; idx < 33 * 32; idx += NTHREADS) {
        int v = idx >> 5, cc = idx & 31;
        float sacc = p.ada_b[layer * 6144 + col0 + cc];
#pragma unroll
        for (int k8 = 0; k8 < 8; ++k8) sacc += red[(k8 * 33 + v) * 32 + cc];
        p.mod[(size_t)(layer * 33 + v) * 6144 + col0 + cc] = sacc;
      }
      __syncthreads();
    } else if (item < NA + J4) {
      const int job = item - NA;
      if (job < J0) {
        transpose_job(p.even_w_in, 4096, p.wt_in0, (job >> 4) * 64, (job & 15) * 64, 0, sm);
      } else if (job < J1) {
        int j = job - J0;
        transpose_job(p.even_w_out, 1024, p.wt_out0, (j >> 4) * 64, (j & 15) * 64, 0, sm);
      } else if (job < J2) {
        int j = job - J1;
        transpose_job(p.odd_w_in, 2832, p.wt_in1, (j >> 4) * 64, (j & 15) * 64, 1, sm);
      } else if (job < J3) {
        int j = job - J2;
        transpose_job(p.odd_w_out, 1024, p.wt_out1, (j >> 4) * 64, (j & 15) * 64, 0, sm);
      } else {
        int j = job - J3;
        const int layer = j >> 8, hp = (j >> 4) & 15, kt = j & 15;
        const int lane = tid & 63, wave = tid >> 6, q = lane >> 4, l15 = lane & 15;
        const float* wq = p.peer_w_q + ((size_t)layer * 1024 + kt * 64 + wave * 16 + l15) * 2048 + hp * 128;
        const float* ky = p.peer_keys + ((size_t)(layer * 16 + hp) * 128) * 128;
        f32x4 acc[8];
#pragma unroll
        for (int nt = 0; nt < 8; ++nt) acc[nt] = f32x4{0.f, 0.f, 0.f, 0.f};
#pragma unroll
        for (int ks = 0; ks < 4; ++ks) {
          f32x4 a0 = *(const f32x4*)(wq + ks * 32 + q * 8), a1 = *(const f32x4*)(wq + ks * 32 + q * 8 + 4);
          bf16x8 af = packfrag(a0, a1);
#pragma unroll
          for (int nt = 0; nt < 8; ++nt) {
            const float* kp = ky + (size_t)(nt * 16 + l15) * 128 + ks * 32 + q * 8;
            f32x4 b0 = *(const f32x4*)kp, b1 = *(const f32x4*)(kp + 4);
            acc[nt] = mfma16(af, packfrag(b0, b1), acc[nt]);
          }
        }
#pragma unroll
        for (int nt = 0; nt < 8; ++nt) {
          uint2 ov;
          ov.x = pack2(acc[nt][0], acc[nt][1]);
          ov.y = pack2(acc[nt][2], acc[nt][3]);
          *(uint2*)(p.wt_q + (size_t)layer * 2048 * 1024 + (size_t)(hp * 128 + nt * 16 + l15) * 1024 + kt * 64 + wave * 16 + q * 4) = ov;
        }
      }
    } else {
      const int lane = tid & 63, wave = tid >> 6;
      const int row0 = (item - NA - J4) * 32 + wave * 8;
#pragma unroll 1
      for (int rb = 0; rb < 8; rb += 4) {
        f32x4 v[4][4];
#pragma unroll
        for (int rr = 0; rr < 4; ++rr) {
          const int row = row0 + rb + rr;
          const int tab = row >> 15, r = row & 32767;
          const float* src = (tab == 0 ? p.peer_u : p.peer_v) + (size_t)r * 1024 + lane * 16;
#pragma unroll
          for (int i = 0; i < 4; ++i) v[rr][i] = *(const f32x4*)(src + i * 4);
        }
#pragma unroll
        for (int rr = 0; rr < 4; ++rr) {
          const int row = row0 + rb + rr;
          const int tab = row >> 15, r = row & 32767;
          float mx = 0.f;
#pragma unroll
          for (int i = 0; i < 4; ++i)
#pragma unroll
            for (int k = 0; k < 4; ++k) mx = fmaxf(mx, fabsf(v[rr][i][k]));
          mx = rows_max(grp16_max(mx));
          float sc = mx > 0.f ? mx * (1.f / 127.f) : 1.f;
          float inv = 1.f / sc;
          u32x4 o;
#pragma unroll
          for (int i = 0; i < 4; ++i) {
            unsigned w = 0;
#pragma unroll
            for (int k = 0; k < 4; ++k) {
              float qf = rintf(v[rr][i][k] * inv);
              qf = fminf(fmaxf(qf, -127.f), 127.f);
              w |= ((unsigned)((int)qf + 128)) << (8 * k);
            }
            o[i] = w;
          }
          *(u32x4*)((tab == 0 ? p.u_q : p.v_q) + (size_t)r * 1024 + lane * 16) = o;
          if (lane == 0) (tab == 0 ? p.u_sc : p.v_sc)[r] = sc;
        }
      }
    }
  }
}

DI void phase_modulate(const Params& p, const float* xlat, const float* xctx, int nrows, int layer, int which) {
  const int lane = get_tid() & 63, wave = get_tid() >> 6;
  const float* nw = p.norm_w + (layer * 2 + which) * 1024;
  for (int row = blockIdx.x * 4 + wave; row < nrows; row += gridDim.x * 4) {
    const float* xr = row < NLAT ? xlat + (size_t)row * 1024 : xctx + (size_t)(row - NLAT) * 1024;
    int vec = vec_of_row(row);
    const float* sh = modp(p, layer, vec, which * 3 + 0);
    const float* sc = modp(p, layer, vec, which * 3 + 1);
    f32x4 v[4];
    float ss = 0.f;
#pragma unroll
    for (int i = 0; i < 4; ++i) {
      v[i] = *(const f32x4*)(xr + i * 256 + lane * 4);
      ss += v[i][0] * v[i][0] + v[i][1] * v[i][1] + v[i][2] * v[i][2] + v[i][3] * v[i][3];
    }
    ss = wave_sum(ss);
    float rstd = rsqrtf(ss * (1.f / 1024.f) + 1e-6f);
#pragma unroll
    for (int i = 0; i < 4; ++i) {
      int c0 = i * 256 + lane * 4;
      float4 w = *(const float4*)(nw + c0), s1 = *(const float4*)(sc + c0), s0 = *(const float4*)(sh + c0);
      float a = v[i][0] * rstd * w.x * (1.f + s1.x) + s0.x;
      float b = v[i][1] * rstd * w.y * (1.f + s1.y) + s0.y;
      float c = v[i][2] * rstd * w.z * (1.f + s1.z) + s0.z;
      float d = v[i][3] * rstd * w.w * (1.f + s1.w) + s0.w;
      uint2 o;
      o.x = pack2(a, b);
      o.y = pack2(c, d);
      *(uint2*)(p.mix + (size_t)row * 1024 + c0) = o;
    }
  }
}

enum { EPI_IN0 = 0, EPI_IN1 = 1, EPI_OUT = 2, EPI_PQ = 3 };
template <int EPI>
DI void phase_gemm(const Params& p, const bf16_t* A, const bf16_t* Bt, int M, int N, char* smem, int layer,
                           const float* xin_lat, const float* xin_ctx, int dry = 0) {
  constexpr int MI = 8;
  bf16_t* sbase = (bf16_t*)smem;
  const int tid = get_tid(), lane = tid & 63, wave = tid >> 6, q = lane >> 4, l15 = lane & 15;
  const int wm = wave >> 1, wn = wave & 1;
  const int ntn = N / 128, ntm = M / 256;
  const int lr = tid >> 2, lc = (tid & 3) * 8;
  const int xcd = blockIdx.x & 7, lcl = blockIdx.x >> 3, nl = gridDim.x >> 3;
  const int ngn = (ntn + 7) >> 3, ngm = (ntm + 7) >> 3;
  for (int wi = lcl; wi < ((ngn * ngm + 7) >> 3) * 64; wi += nl) {
    const int sid = (wi >> 6) * 8 + xcd, within = wi & 63;
    if (sid >= ngn * ngm) continue;
    const int tm = (sid / ngn) * 8 + (within >> 3), tn = (sid % ngn) * 8 + (within & 7);
    if (tm >= ntm || tn >= ntn) continue;
    f32x4 acc[MI][4];
#pragma unroll
    for (int i = 0; i < MI; ++i)
#pragma unroll
      for (int j = 0; j < 4; ++j) acc[i][j] = f32x4{0.f, 0.f, 0.f, 0.f};
    const bf16_t* Ag = A + (size_t)(tm * 256 + lr) * 1024 + lc;
    const bf16_t* Bg = Bt + (size_t)(tn * 128 + lr) * 1024 + lc;
    u32x4 ra[4], rb[2];
#pragma unroll
    for (int i = 0; i < 4; ++i) ra[i] = *(const u32x4*)(Ag + (size_t)i * 64 * 1024);
#pragma unroll
    for (int i = 0; i < 2; ++i) rb[i] = *(const u32x4*)(Bg + (size_t)i * 64 * 1024);
    __syncthreads();
    for (int kt = 0; kt < 32; ++kt) {
      bf16_t* cA = sbase + (kt & 1) * (384 * 48);
      bf16_t* cB = cA + 256 * 48;
#pragma unroll
      for (int i = 0; i < 4; ++i) *(u32x4*)(cA + (lr + 64 * i) * 48 + lc) = ra[i];
#pragma unroll
      for (int i = 0; i < 2; ++i) *(u32x4*)(cB + (lr + 64 * i) * 48 + lc) = rb[i];
      __syncthreads();
      if (kt + 1 < 32) {
#pragma unroll
        for (int i = 0; i < 4; ++i) ra[i] = *(const u32x4*)(Ag + (size_t)i * 64 * 1024 + (kt + 1) * 32);
#pragma unroll
        for (int i = 0; i < 2; ++i) rb[i] = *(const u32x4*)(Bg + (size_t)i * 64 * 1024 + (kt + 1) * 32);
      }
      bf16x8 bfr[4];
#pragma unroll
      for (int j = 0; j < 4; ++j) bfr[j] = ldfrag(cB + (wn * 64 + j * 16 + l15) * 48 + q * 8);
#pragma unroll
      for (int i = 0; i < MI; ++i) {
        bf16x8 af = ldfrag(cA + (wm * 128 + i * 16 + l15) * 48 + q * 8);
#pragma unroll
        for (int j = 0; j < 4; ++j) acc[i][j] = mfma16(bfr[j], af, acc[i][j]);
      }
    }
    const int colbase = tn * 128 + wn * 64;
    const int rowbase = tm * 256 + wm * 128;
    if (EPI == EPI_IN0 || EPI == EPI_IN1) {
      const int ld = EPI == EPI_IN0 ? LD0 : LD1;
      bool ropegrp = EPI == EPI_IN0 ? (colbase < 1024) : (colbase >= 2048 && colbase < 2688);
      bool lat = rowbase < NLAT;
      if (ropegrp && lat) {
#pragma unroll
        for (int i = 0; i < MI; ++i) {
          int row = rowbase + i * 16 + l15;
          int t = row & 2047, gr = t >> 6, gc = t & 63;
          const f32x4* pr = (const f32x4*)(p.rope + (gr * 16 + q * 4) * 2);
          const f32x4* pc = (const f32x4*)(p.rope + (gc * 16 + q * 4) * 2);
          f32x4 r0 = pr[0], r1 = pr[1], c0 = pc[0], c1 = pc[1];
          float crc[4] = {r0[0], r0[2], r1[0], r1[2]}, crs[4] = {r0[1], r0[3], r1[1], r1[3]};
          float ccc[4] = {c0[0], c0[2], c1[0], c1[2]}, ccs[4] = {c0[1], c0[3], c1[1], c1[3]};
          float o1[4], o2[4], o3[4], o4[4];
#pragma unroll
          for (int r = 0; r < 4; ++r) {
            float x1 = acc[i][0][r], x2 = acc[i][1][r], x3 = acc[i][2][r], x4 = acc[i][3][r];
            o1[r] = x1 * crc[r] - x2 * crs[r];
            o2[r] = x2 * crc[r] + x1 * crs[r];
            o3[r] = x3 * ccc[r] - x4 * ccs[r];
            o4[r] = x4 * ccc[r] + x3 * ccs[r];
          }
          bf16_t* o = p.proj + (size_t)row * ld + colbase + q * 4;
          *(uint2*)(o) = uint2{pack2(o1[0], o1[1]), pack2(o1[2], o1[3])};
          *(uint2*)(o + 16) = uint2{pack2(o2[0], o2[1]), pack2(o2[2], o2[3])};
          *(uint2*)(o + 32) = uint2{pack2(o3[0], o3[1]), pack2(o3[2], o3[3])};
          *(uint2*)(o + 48) = uint2{pack2(o4[0], o4[1]), pack2(o4[2], o4[3])};
        }
      } else {
#pragma unroll
        for (int i = 0; i < MI; ++i) {
          int row = rowbase + i * 16 + l15;
#pragma unroll
          for (int j = 0; j < 4; ++j) {
            int col = colbase + j * 16 + q * 4;
            if (EPI == EPI_IN0 || col < 2832)
              *(uint2*)(p.proj + (size_t)row * ld + col) = uint2{pack2(acc[i][j][0], acc[i][j][1]), pack2(acc[i][j][2], acc[i][j][3])};
          }
        }
      }
    } else if (EPI == EPI_OUT) {
#pragma unroll
      for (int i = 0; i < MI; ++i) {
        int row = rowbase + i * 16 + l15;
        const float* g1 = modp(p, layer, vec_of_row(row), 2);
        const float* xi = row < NLAT ? xin_lat + (size_t)row * 1024 : xin_ctx + (size_t)(row - NLAT) * 1024;
        float* xo = row < NLAT ? p.out + (size_t)row * 1024 : p.xc + (size_t)(row - NLAT) * 1024;
#pragma unroll
        for (int j = 0; j < 4; ++j) {
          int col = colbase + j * 16 + q * 4;
          f32x4 xv = *(const f32x4*)(xi + col), gv = *(const f32x4*)(g1 + col);
          f32x4 nv;
#pragma unroll
          for (int r = 0; r < 4; ++r) nv[r] = xv[r] + gv[r] * acc[i][j][r];
          if (!dry || nv[0] == -12345.678f) *(f32x4*)(xo + col) = nv;
        }
      }
    } else {
#pragma unroll
      for (int i = 0; i < MI; ++i) {
        int row = rowbase + i * 16 + l15;
#pragma unroll
        for (int j = 0; j < 4; ++j) {
          int col = colbase + j * 16 + q * 4;
          *(f32x4*)(p.pq + (size_t)row * 2048 + col) = acc[i][j];
        }
      }
    }
  }
}

template <int DV, int NC>
DI void flash_item(char* smem, const bf16_t* Qb, int ld, const bf16_t* Kc, const bf16_t* Vc, const bf16_t* Kl,
                   const bf16_t* Vl, int l_lo, int l_hi, int qpos0, int window, float sink, float scale,
                   f32x4 (&o)[NC][DV / 16], float (&m)[NC], float (&l)[NC]) {
  bf16_t* sK = (bf16_t*)smem;
  bf16_t* sVt = sK + NC * 64 * 80;
  const int tid0 = get_tid();
  const float L2E = 1.4426950408889634f;
  const float sc2 = scale * L2E;
  bf16x8 qf[NC][2];
  {
  const int lane = tid0 & 63, wave = tid0 >> 6, q = lane >> 4, l15 = lane & 15;
#pragma unroll
  for (int c = 0; c < NC; ++c)
#pragma unroll
    for (int ks = 0; ks < 2; ++ks)
      qf[c][ks] = *(const bf16x8*)(Qb + (size_t)(wave * 16 + l15) * ld + c * 64 + ks * 32 + q * 8);
  }
#pragma unroll
  for (int c = 0; c < NC; ++c) {
    m[c] = sink == -INFINITY ? -INFINITY : sink * L2E;
    l[c] = sink == -INFINITY ? 0.f : 1.f;
#pragma unroll
    for (int n = 0; n < DV / 16; ++n) o[c][n] = f32x4{0.f, 0.f, 0.f, 0.f};
  }
  const int nlt = l_hi > l_lo ? (l_hi - l_lo) / 64 : 0;
  const int ntiles = 4 + nlt;
  u32x4 kreg[NC][2], vreg[DV / 32];
  auto load_tile = [&](int it2) {
    const int tidl = tid0;
    const bf16_t *Kr2, *Vr2;
    if (it2 < 4) {
      Kr2 = Kc + (size_t)(it2 * 64) * ld;
      Vr2 = Vc + (size_t)(it2 * 64) * ld;
    } else {
      int kp = l_lo + (it2 - 4) * 64;
      Kr2 = Kl + (size_t)kp * ld;
      Vr2 = Vl + (size_t)kp * ld;
    }
    int key = tidl >> 2, part = tidl & 3;
#pragma unroll
    for (int c = 0; c < NC; ++c) {
      const bf16_t* sp = Kr2 + (size_t)key * ld + c * 64 + part * 16;
      kreg[c][0] = *(const u32x4*)sp;
      kreg[c][1] = *(const u32x4*)(sp + 8);
    }
    int vkey = tidl & 63, cg4 = tidl >> 6;
#pragma unroll
    for (int i = 0; i < DV / 32; ++i) vreg[i] = *(const u32x4*)(Vr2 + (size_t)vkey * ld + (cg4 + 4 * i) * 8);
  };
  load_tile(0);
  for (int it = 0; it < ntiles; ++it) {
    int tid = tid0;
    asm volatile("" : "+v"(tid));
    const int lane = tid & 63, wave = tid >> 6, q = lane >> 4, l15 = lane & 15;
    const int kpos0 = it < 4 ? -(1 << 28) : l_lo + (it - 4) * 64;
    __syncthreads();
    {
      int key = tid >> 2, part = tid & 3;
#pragma unroll
      for (int c = 0; c < NC; ++c) {
        *(u32x4*)(sK + (c * 64 + key) * 80 + part * 16) = kreg[c][0];
        *(u32x4*)(sK + (c * 64 + key) * 80 + part * 16 + 8) = kreg[c][1];
      }
      int vkey = tid & 63, cg4 = tid >> 6;
#pragma unroll
      for (int i = 0; i < DV / 32; ++i) {
        int e0 = (cg4 + 4 * i) * 8;
#pragma unroll
        for (int j = 0; j < 4; ++j) {
          sVt[(e0 + 2 * j) * 72 + vkey] = (bf16_t)(vreg[i][j] & 0xffffu);
          sVt[(e0 + 2 * j + 1) * 72 + vkey] = (bf16_t)(vreg[i][j] >> 16);
        }
      }
    }
    __syncthreads();
    if (it + 1 < ntiles) load_tile(it + 1);
    bf16x8 pf[NC][2];
#pragma unroll
    for (int c = 0; c < NC; ++c) {
      f32x4 s[4];
#pragma unroll
      for (int nt = 0; nt < 4; ++nt) {
        s[nt] = f32x4{0.f, 0.f, 0.f, 0.f};
#pragma unroll
        for (int ks = 0; ks < 2; ++ks)
          s[nt] = mfma16(ldfrag(sK + (c * 64 + nt * 16 + l15) * 80 + ks * 32 + q * 8), qf[c][ks], s[nt]);
      }
      float mx = -INFINITY;
      if (NC == 1 && kpos0 >= 0) {
#pragma unroll
        for (int nt = 0; nt < 4; ++nt)
#pragma unroll
          for (int r = 0; r < 4; ++r) {
            int d = (kpos0 + nt * 16 + q * 4 + r) - (qpos0 + wave * 16 + l15);
            if (d > window || d < -window) s[nt][r] = -INFINITY;
          }
      }
#pragma unroll
      for (int nt = 0; nt < 4; ++nt)
#pragma unroll
        for (int r = 0; r < 4; ++r) mx = fmaxf(mx, s[nt][r]);
      mx = rows_max(mx) * sc2;
      const float mn = fmaxf(m[c], mx);
      const float alpha = __builtin_amdgcn_exp2f(m[c] - mn);
      float rs = 0.f;
#pragma unroll
      for (int nt = 0; nt < 4; ++nt)
#pragma unroll
        for (int r = 0; r < 4; ++r) {
          float pv = __builtin_amdgcn_exp2f(__builtin_fmaf(s[nt][r], sc2, -mn));
          s[nt][r] = pv;
          rs += pv;
        }
      rs = rows_sum(rs);
      l[c] = l[c] * alpha + rs;
      m[c] = mn;
#pragma unroll
      for (int n = 0; n < DV / 16; ++n)
#pragma unroll
        for (int r = 0; r < 4; ++r) o[c][n][r] *= alpha;
      pf[c][0] = packfrag(s[0], s[1]);
      pf[c][1] = packfrag(s[2], s[3]);
    }
#pragma unroll
    for (int ks = 0; ks < 2; ++ks) {
#pragma unroll
      for (int n = 0; n < DV / 16; ++n) {
        bf16x8 vf = ldfrag_perm(sVt + (n * 16 + l15) * 72, ks, q);
#pragma unroll
        for (int c = 0; c < NC; ++c) o[c][n] = mfma16(vf, pf[c][ks], o[c][n]);
      }
    }
  }
}

DI void diff_item(const Params& p, char* smem, int b, int h, int qb, bool is_ctx, float lam) {
  const int lane = get_tid() & 63, wave = get_tid() >> 6, q = lane >> 4, l15 = lane & 15;
  const int ctxrow0 = NLAT + b * LL;
  const int qrow0 = is_ctx ? ctxrow0 + qb * 64 : b * TT + qb * 64;
  const bf16_t* Qb = p.proj + (size_t)qrow0 * LD0 + h * 128;
  const bf16_t* Kc = p.proj + (size_t)ctxrow0 * LD0 + 512 + h * 128;
  const bf16_t* Vc = p.proj + (size_t)ctxrow0 * LD0 + 1024 + h * 128;
  const bf16_t* Kl = p.proj + (size_t)(b * TT) * LD0 + 512 + h * 128;
  const bf16_t* Vl = p.proj + (size_t)(b * TT) * LD0 + 1024 + h * 128;
  f32x4 o[2][8];
  float m[2], l[2];
  flash_item<128, 2>(smem, Qb, LD0, Kc, Vc, Kl, Vl, 0, is_ctx ? 0 : TT, 0, -1, -INFINITY, 0.125f, o, m, l);
  const float* sw = p.diff_subln_w;
  const float i0 = 1.f / l[0], i1 = lam / l[1];
  float ss = 0.f;
#pragma unroll
  for (int n = 0; n < 8; ++n)
#pragma unroll
    for (int r = 0; r < 4; ++r) {
      float v = o[0][n][r] * i0 - o[1][n][r] * i1;
      o[0][n][r] = v;
      ss += v * v;
    }
  ss = rows_sum(ss);
  const float rstd = rsqrtf(ss * (1.f / 128.f) + 1e-6f) * 0.8f;
  const int row = qrow0 + wave * 16 + l15;
#pragma unroll
  for (int n = 0; n < 8; ++n) {
    f32x4 w4 = *(const f32x4*)(sw + n * 16 + q * 4);
    uint2 ov;
    ov.x = pack2(o[0][n][0] * rstd * w4[0], o[0][n][1] * rstd * w4[1]);
    ov.y = pack2(o[0][n][2] * rstd * w4[2], o[0][n][3] * rstd * w4[3]);
    *(uint2*)(p.mix + (size_t)row * 1024 + h * 128 + n * 16 + q * 4) = ov;
  }
}

DI void swa_item(const Params& p, char* smem, int b, int h, int qb) {
  const int lane = get_tid() & 63, wave = get_tid() >> 6, q = lane >> 4, l15 = lane & 15;
  const int kvh = h >> 2;
  const int ctxrow0 = NLAT + b * LL;
  const int qrow0 = b * TT + qb * 64;
  const bf16_t* Qb = p.proj + (size_t)qrow0 * LD1 + 2048 + h * 64;
  const bf16_t* Kc = p.proj + (size_t)ctxrow0 * LD1 + 2560 + kvh * 64;
  const bf16_t* Vc = p.proj + (size_t)ctxrow0 * LD1 + 2688 + kvh * 64;
  const bf16_t* Kl = p.proj + (size_t)(b * TT) * LD1 + 2560 + kvh * 64;
  const bf16_t* Vl = p.proj + (size_t)(b * TT) * LD1 + 2688 + kvh * 64;
  int lo = qb * 64 - 128, hi = qb * 64 + 64 + 128;
  if (lo < 0) lo = 0;
  if (hi > TT) hi = TT;
  f32x4 o[1][4];
  float m[1], l[1];
  flash_item<64, 1>(smem, Qb, LD1, Kc, Vc, Kl, Vl, lo, hi, qb * 64, 128, p.swa_sink[h], 0.125f, o, m, l);
  const float inv = 1.f / l[0];
  const int row = qrow0 + wave * 16 + l15;
#pragma unroll
  for (int n = 0; n < 4; ++n) {
    uint2 ov;
    ov.x = pack2(o[0][n][0] * inv, o[0][n][1] * inv);
    ov.y = pack2(o[0][n][2] * inv, o[0][n][3] * inv);
    *(uint2*)(p.mix + (size_t)row * 1024 + 512 + h * 64 + n * 16 + q * 4) = ov;
  }
}

DI void hgrn_item(const Params& p, char* smem, int b, int head) {
  bf16_t* sQt = (bf16_t*)smem;
  bf16_t* sKt = sQt + 32 * 72;
  bf16_t* sQS = sKt + 32 * 72;
  bf16_t* sKST = sQS + 32 * 72;
  bf16_t* sVT = sKST + 64 * 40;
  bf16_t* sAtt = sVT + 64 * 40;
  bf16_t* sST = sAtt + 32 * 40;
  float* sO = (float*)(sST + 64 * 72);
  float* sGs = sO + 32 * 65;
  float* sG16 = sGs + 256;
  float* sEB = sG16 + 64;
  const int tid0 = get_tid();
  const int ch = head * 64 + (tid0 & 63);
  float lb;
  {
    float a0 = p.hgrn_lb[ch], a1 = p.hgrn_lb[512 + ch], a2 = p.hgrn_lb[1024 + ch];
    float mx = fmaxf(a0, fmaxf(a1, a2));
    float e0 = expf(a0 - mx), e1 = expf(a1 - mx), e2 = expf(a2 - mx);
    lb = e0 / (e0 + e1 + e2);
  }
  for (int dir = 0; dir < 2; ++dir) {
    const bool rev = dir == 1;
    f32x4 S[4];
    bf16_t nq[8], ni[8], nf[8];
#pragma unroll
    for (int n = 0; n < 4; ++n) S[n] = f32x4{0.f, 0.f, 0.f, 0.f};
    __syncthreads();
    for (int i = tid0; i < 64 * 72; i += NTHREADS) sST[i] = 0;
    for (int step = 0; step < 72; ++step) {
      int tid = tid0;
      asm volatile("" : "+v"(tid));
      const int lane = tid & 63, wave = tid >> 6, q = lane >> 4, l15 = lane & 15;
      const int c = tid & 63, tg = tid >> 6;
      const bool isctx = step < 8;
      const int n = isctx ? LL : TT;
      const int j = isctx ? step : step - 8;
      const int rowseg = isctx ? NLAT + b * LL : b * TT;
      float qv[8], kk[8], vv[8], cs[8];
      float run = 0.f;
      if (step == 0) {
#pragma unroll
        for (int jj = 0; jj < 8; ++jj) {
          int pp = tg * 8 + jj;
          int tok = rev ? n - 1 - (32 * j + pp) : 32 * j + pp;
          const bf16_t* pr = p.proj + (size_t)(rowseg + tok) * LD0;
          nq[jj] = pr[1536 + ch];
          ni[jj] = pr[2048 + ch];
          nf[jj] = pr[(rev ? 3072 : 2560) + ch];
        }
      }
#pragma unroll
      for (int jj = 0; jj < 8; ++jj) {
        float qr = bf2f(nq[jj]), ir = bf2f(ni[jj]), fl = bf2f(nf[jj]);
        qv[jj] = silu_fast(qr) * 0.125f;
        float f = lb + (1.f - lb) * __fdividef(1.f, 1.f + __expf(-fl));
        kk[jj] = 1.f - f;
        vv[jj] = ir;
        run += __logf(f);
        cs[jj] = run;
      }
      if (step + 1 < 72) {
        const int s2 = step + 1;
        const bool isctx2 = s2 < 8;
        const int n2 = isctx2 ? LL : TT;
        const int j2 = isctx2 ? s2 : s2 - 8;
        const int rowseg2 = isctx2 ? NLAT + b * LL : b * TT;
#pragma unroll
        for (int jj = 0; jj < 8; ++jj) {
          int pp = tg * 8 + jj;
          int tok = rev ? n2 - 1 - (32 * j2 + pp) : 32 * j2 + pp;
          const bf16_t* pr = p.proj + (size_t)(rowseg2 + tok) * LD0;
          nq[jj] = pr[1536 + ch];
          ni[jj] = pr[2048 + ch];
          nf[jj] = pr[(rev ? 3072 : 2560) + ch];
        }
      }
      sGs[tg * 64 + c] = run;
      if (tg == 2) sG16[c] = cs[0];
      __syncthreads();
      {
        float g0 = sGs[c], g1 = sGs[64 + c], g2 = sGs[128 + c], g3 = sGs[192 + c];
        float off = tg == 0 ? 0.f : (tg == 1 ? g0 : (tg == 2 ? g0 + g1 : g0 + g1 + g2));
        float blast = g0 + g1 + g2 + g3;
        float ref = g0 + g1 + sG16[c];
#pragma unroll
        for (int jj = 0; jj < 8; ++jj) {
          int pp = tg * 8 + jj;
          float bj = off + cs[jj];
          sQt[pp * 72 + c] = f2bf(qv[jj] * __expf(bj - ref));
          sKt[pp * 72 + c] = f2bf(kk[jj] * __expf(ref - bj));
          sQS[pp * 72 + c] = f2bf(qv[jj] * __expf(bj));
          sKST[c * 40 + pp] = f2bf(kk[jj] * __expf(blast - bj));
          sVT[c * 40 + pp] = f2bf(vv[jj]);
        }
        if (tg == 0) sEB[c] = __expf(blast);
      }
      __syncthreads();
      {
        const int mt = wave & 1, nt0 = (wave >> 1) * 2;
        f32x4 aT[2];
#pragma unroll
        for (int kt = 0; kt < 2; ++kt) {
          aT[kt] = f32x4{0.f, 0.f, 0.f, 0.f};
#pragma unroll
          for (int ks = 0; ks < 2; ++ks)
            aT[kt] = mfma16(ldfrag(sKt + (kt * 16 + l15) * 72 + ks * 32 + q * 8),
                            ldfrag(sQt + (mt * 16 + l15) * 72 + ks * 32 + q * 8), aT[kt]);
#pragma unroll
          for (int r = 0; r < 4; ++r) {
            int ki = kt * 16 + q * 4 + r, qi = mt * 16 + l15;
            if (ki > qi) aT[kt][r] = 0.f;
          }
        }
        const bf16x8 attf = packfrag(aT[0], aT[1]);
        const bf16x8 q0 = ldfrag(sQS + (mt * 16 + l15) * 72 + q * 8), q1 = ldfrag(sQS + (mt * 16 + l15) * 72 + 32 + q * 8);
#pragma unroll
        for (int t2 = 0; t2 < 2; ++t2) {
          int nt = nt0 + t2;
          f32x4 a = f32x4{0.f, 0.f, 0.f, 0.f};
          a = mfma16(ldfrag_perm(sVT + (nt * 16 + l15) * 40, 0, q), attf, a);
          a = mfma16(ldfrag(sST + (nt * 16 + l15) * 72 + q * 8), q0, a);
          a = mfma16(ldfrag(sST + (nt * 16 + l15) * 72 + 32 + q * 8), q1, a);
#pragma unroll
          for (int r = 0; r < 4; ++r) sO[(mt * 16 + l15) * 65 + nt * 16 + q * 4 + r] = a[r];
        }
      }
      __syncthreads();
      {
        bf16x8 af = ldfrag(sKST + (wave * 16 + l15) * 40 + q * 8);
        float eb[4];
#pragma unroll
        for (int r = 0; r < 4; ++r) eb[r] = sEB[wave * 16 + q * 4 + r];
#pragma unroll
        for (int nt = 0; nt < 4; ++nt) {
#pragma unroll
          for (int r = 0; r < 4; ++r) S[nt][r] *= eb[r];
          S[nt] = mfma16(af, ldfrag(sVT + (nt * 16 + l15) * 40 + q * 8), S[nt]);
          uint2 w;
          w.x = pack2(S[nt][0], S[nt][1]);
          w.y = pack2(S[nt][2], S[nt][3]);
          *(uint2*)(sST + (nt * 16 + l15) * 72 + wave * 16 + q * 4) = w;
        }
        int pp = tid >> 3, eg = tid & 7;
        int tok = rev ? n - 1 - (32 * j + pp) : 32 * j + pp;
        size_t row = (size_t)(rowseg + tok);
        bf16_t* dst = p.mix + row * 1024 + 512 + head * 64 + eg * 8;
        float val[8];
#pragma unroll
        for (int k = 0; k < 8; ++k) val[k] = sO[pp * 65 + eg * 8 + k];
        if (!rev) {
          uint4 w;
          w.x = pack2(val[0], val[1]);
          w.y = pack2(val[2], val[3]);
          w.z = pack2(val[4], val[5]);
          w.w = pack2(val[6], val[7]);
          *(uint4*)dst = w;
        } else {
          uint4 of = *(const uint4*)dst;
          unsigned ow[4] = {of.x, of.y, of.z, of.w};
          float ss = 0.f;
#pragma unroll
          for (int k = 0; k < 4; ++k) {
            val[2 * k] += __uint_as_float(ow[k] << 16);
            val[2 * k + 1] += __uint_as_float(ow[k] & 0xffff0000u);
          }
#pragma unroll
          for (int k = 0; k < 8; ++k) ss += val[k] * val[k];
          ss += __shfl_xor(ss, 1);
          ss += __shfl_xor(ss, 2);
          ss += __shfl_xor(ss, 4);
          float rstd = rsqrtf(ss * (1.f / 64.f) + 1e-6f);
          uint4 gq = *(const uint4*)(p.proj + row * LD0 + 3584 + head * 64 + eg * 8);
          unsigned gw[4] = {gq.x, gq.y, gq.z, gq.w};
          float outv[8];
#pragma unroll
          for (int k = 0; k < 4; ++k) {
            float ga = __uint_as_float(gw[k] << 16), gb = __uint_as_float(gw[k] & 0xffff0000u);
            outv[2 * k] = val[2 * k] * rstd * p.hgrn_norm_w[eg * 8 + 2 * k] * silu_fast(ga);
            outv[2 * k + 1] = val[2 * k + 1] * rstd * p.hgrn_norm_w[eg * 8 + 2 * k + 1] * silu_fast(gb);
          }
          uint4 w;
          w.x = pack2(outv[0], outv[1]);
          w.y = pack2(outv[2], outv[3]);
          w.z = pack2(outv[4], outv[5]);
          w.w = pack2(outv[6], outv[7]);
          *(uint4*)dst = w;
        }
      }
    }
  }
}

DI void gdn_item(const Params& p, char* smem, int b, int head, int dir, int ehalf) {
  bf16_t* sQ = (bf16_t*)smem;
  bf16_t* sK = sQ + 64 * 136;
  bf16_t* sW = sK + 64 * 136;
  bf16_t* sV = sW + 64 * 136;
  float* sA = (float*)(sV + 64 * 72);
  float* sG = sA + 64 * 64;
  float* sBeta = sG + 64;
  float* sRq = sBeta + 64;
  float* sRk = sRq + 64;
  float* sEg = sRk + 64;
  bf16_t* sKdT = sW;
  bf16_t* sAtt = (bf16_t*)sA;
  const int tid0 = get_tid();
  const bool rev = dir == 1;
  const float neg_a = -expf(p.gdn_a_log[dir * 4 + head]);
  const float dtb = p.gdn_dt_bias[dir * 4 + head];
  bf16_t* gout = (dir == 0 ? p.gdn_of : p.gdn_ob);
  f32x4 S[8];
#pragma unroll
  for (int i = 0; i < 8; ++i) S[i] = f32x4{0.f, 0.f, 0.f, 0.f};
  for (int step = 0; step < 36; ++step) {
    int tid = tid0;
    asm volatile("" : "+v"(tid));
    const int lane = tid & 63, wave = tid >> 6, q = lane >> 4, l15 = lane & 15;
    const bool isctx = step < 4;
    const int n = isctx ? LL : TT;
    const int j = isctx ? step : step - 4;
    const int rowseg = isctx ? NLAT + b * LL : b * TT;
    const int lo = rev ? n - 64 * (j + 1) : 64 * j;
    __syncthreads();
    {
      bf16_t* rawA = sW;
      bf16_t* rawV = (bf16_t*)sA;
      const bf16_t* gbase = p.proj + (size_t)rowseg * LD1;
      const u32x4 zz = u32x4{0u, 0u, 0u, 0u};
      u32x4 rq[5], rk[5], rv[3];
#pragma unroll
      for (int i = 0; i < 5; ++i) {
        int chn = tid + 256 * i;
        int row = chn >> 4, part = chn & 15;
        int t = lo - 2 + row;
        bool ok = chn < 1088 && t >= 0 && t < n;
        const bf16_t* gp = gbase + (size_t)(ok ? t : 0) * LD1 + head * 128 + part * 8;
        rq[i] = ok ? *(const u32x4*)gp : zz;
        rk[i] = ok ? *(const u32x4*)(gp + 512) : zz;
      }
#pragma unroll
      for (int i = 0; i < 3; ++i) {
        int chn = tid + 256 * i;
        int row = chn >> 3, part = chn & 7;
        int t = lo - 2 + row;
        bool ok = chn < 544 && t >= 0 && t < n;
        const bf16_t* gp = gbase + (size_t)(ok ? t : 0) * LD1 + 1024 + head * 128 + ehalf * 64 + part * 8;
        rv[i] = ok ? *(const u32x4*)gp : zz;
      }
#pragma unroll
      for (int i = 0; i < 5; ++i) {
        int chn = tid + 256 * i;
        if (chn < 1088) *(u32x4*)(rawA + chn * 8) = rq[i];
      }
#pragma unroll
      for (int i = 0; i < 3; ++i) {
        int chn = tid + 256 * i;
        if (chn < 544) *(u32x4*)(rawV + chn * 8) = rv[i];
      }
      __syncthreads();
      const int c = tid & 127, th = tid >> 7;
      auto conv_from = [&](const bf16_t* raw, int stride, int col, bf16_t* dst, int dstride) {
        float w0 = p.gdn_conv_w[col], w1 = p.gdn_conv_w[1536 + col], w2 = p.gdn_conv_w[2 * 1536 + col],
              w3 = p.gdn_conv_w[3 * 1536 + col], w4 = p.gdn_conv_w[4 * 1536 + col];
        const bf16_t* rp = raw + (th * 32) * stride + c;
        float x0 = bf2f(rp[0]), x1 = bf2f(rp[stride]), x2 = bf2f(rp[2 * stride]), x3 = bf2f(rp[3 * stride]);
#pragma unroll
        for (int tt = 0; tt < 32; ++tt) {
          float x4 = bf2f(rp[(tt + 4) * stride]);
          float y = w0 * x0 + w1 * x1 + w2 * x2 + w3 * x3 + w4 * x4;
          y = silu_fast(y);
          int tl = th * 32 + tt;
          int pp = rev ? 63 - tl : tl;
          dst[pp * dstride + c] = f2bf(y);
          x0 = x1; x1 = x2; x2 = x3; x3 = x4;
        }
      };
      conv_from(rawA, 128, head * 128 + c, sQ, 136);
      if (c < 64) conv_from(rawV, 64, 1024 + head * 128 + ehalf * 64 + c, sV, 72);
      __syncthreads();
#pragma unroll
      for (int i = 0; i < 5; ++i) {
        int chn = tid + 256 * i;
        if (chn < 1088) *(u32x4*)(rawA + chn * 8) = rk[i];
      }
      __syncthreads();
      conv_from(rawA, 128, 512 + head * 128 + c, sK, 136);
      if (tid < 64) {
        int pp = tid;
        int tok = rev ? n - 1 - (64 * j + pp) : 64 * j + pp;
        const bf16_t* pr = p.proj + (size_t)(rowseg + tok) * LD1 + 2816;
        float a = bf2f(pr[dir * 4 + head]), bt = bf2f(pr[8 + dir * 4 + head]);
        float xs = a + dtb;
        float sp = xs > 20.f ? xs : log1pf(expf(xs));
        float g = neg_a * sp;
#pragma unroll
        for (int o = 1; o < 64; o <<= 1) {
          float t = __shfl_up(g, o);
          if (lane >= o) g += t;
        }
        sG[pp] = g;
        sEg[pp] = expf(g);
        sBeta[pp] = sigmoidf_(bt);
      }
    }
    __syncthreads();
    {
      int pp = tid >> 2, part = tid & 3;
      float sq = 0.f, sk = 0.f;
#pragma unroll 8
      for (int k = 0; k < 32; ++k) {
        float a = bf2f(sQ[pp * 136 + part * 32 + k]), bb = bf2f(sK[pp * 136 + part * 32 + k]);
        sq += a * a;
        sk += bb * bb;
      }
      sq += __shfl_xor(sq, 1); sq += __shfl_xor(sq, 2);
      sk += __shfl_xor(sk, 1); sk += __shfl_xor(sk, 2);
      if (part == 0) {
        sRq[pp] = rsqrtf(sq + 1e-6f) * 0.08838834764831845f;
        sRk[pp] = rsqrtf(sk + 1e-6f);
      }
    }
    __syncthreads();
    {
      const int mt = wave;
#pragma unroll
      for (int nt = 0; nt < 4; ++nt) {
        f32x4 a = f32x4{0.f, 0.f, 0.f, 0.f};
        if (nt <= mt) {
#pragma unroll
          for (int ks = 0; ks < 4; ++ks)
            a = mfma16(ldfrag(sK + (mt * 16 + l15) * 136 + ks * 32 + q * 8),
                       ldfrag(sK + (nt * 16 + l15) * 136 + ks * 32 + q * 8), a);
        }
        int jj = nt * 16 + l15;
        float rkj = sRk[jj], gj = sG[jj];
        f32x4 av;
#pragma unroll
        for (int r = 0; r < 4; ++r) {
          int ii = mt * 16 + q * 4 + r;
          float v = 0.f;
          if (ii > jj) v = a[r] * sRk[ii] * rkj * sBeta[ii] * __expf(sG[ii] - gj);
          av[r] = v;
        }
        *(f32x4*)(sA + jj * 64 + mt * 16 + q * 4) = av;
      }
    }
    __syncthreads();
    {
      auto solve = [&](auto UP, int cidx) {
        constexpr bool upart = decltype(UP)::value;
        bf16_t* dstb = upart ? sV + cidx : sW + cidx;
        const bf16_t* srcb = upart ? sV + cidx : sK + cidx;
        constexpr int dstr = upart ? 72 : 136;
#pragma unroll 1
        for (int bi = 0; bi < 4; ++bi) {
          float acc[16];
#pragma unroll
          for (int r = 0; r < 16; ++r) {
            int i = bi * 16 + r;
            float rv = bf2f(srcb[i * dstr]) * sBeta[i];
            if (!upart) rv *= sRk[i] * sEg[i];
            acc[r] = rv;
          }
#pragma unroll 8
          for (int j = 0; j < bi * 16; ++j) {
            float sj = bf2f(dstb[j * dstr]);
            const f32x4* ap = (const f32x4*)(sA + j * 64 + bi * 16);
            f32x4 a0 = ap[0], a1 = ap[1], a2 = ap[2], a3 = ap[3];
#pragma unroll
            for (int k = 0; k < 4; ++k) {
              acc[k] -= a0[k] * sj;
              acc[4 + k] -= a1[k] * sj;
              acc[8 + k] -= a2[k] * sj;
              acc[12 + k] -= a3[k] * sj;
            }
          }
          const float* ab = sA + (bi * 16) * 64 + bi * 16;
#pragma unroll
          for (int r = 0; r < 16; ++r) {
            float sr = acc[r];
            dstb[(bi * 16 + r) * dstr] = f2bf(sr);
#pragma unroll
            for (int r2 = r + 1; r2 < 16; ++r2) acc[r2] -= ab[r * 64 + r2] * sr;
            if ((r & 7) == 7) __builtin_amdgcn_sched_barrier(0);
          }
        }
      };
      if (tid < 64) solve(std::true_type{}, tid);
      else if (tid < 192) solve(std::false_type{}, tid - 64);
    }
    __syncthreads();
    f32x4 vn[4], oo[4];
    {
      bf16x8 sf[4];
#pragma unroll
      for (int ks = 0; ks < 4; ++ks) sf[ks] = packfrag(S[2 * ks], S[2 * ks + 1]);
#pragma unroll
      for (int mt = 0; mt < 4; ++mt) {
        f32x4 ws = f32x4{0.f, 0.f, 0.f, 0.f}, qs = f32x4{0.f, 0.f, 0.f, 0.f};
#pragma unroll
        for (int ks = 0; ks < 4; ++ks) {
          ws = mfma16(ldfrag_perm(sW + (mt * 16 + l15) * 136, ks, q), sf[ks], ws);
          qs = mfma16(ldfrag_perm(sQ + (mt * 16 + l15) * 136, ks, q), sf[ks], qs);
        }
#pragma unroll
        for (int r = 0; r < 4; ++r) {
          int ii = mt * 16 + q * 4 + r;
          vn[mt][r] = bf2f(sV[ii * 72 + wave * 16 + l15]) - ws[r];
          oo[mt][r] = qs[r] * sRq[ii] * sEg[ii];
        }
        asm volatile("" : "+v"(vn[mt]), "+v"(oo[mt]));
      }
    }
    __syncthreads();
    {
      const int d = tid & 127, hf = tid >> 7;
      const float glast = sG[63];
#pragma unroll 4
      for (int jj = 0; jj < 32; ++jj) {
        int jt = hf * 32 + jj;
        sKdT[d * 68 + jt] = f2bf(bf2f(sK[jt * 136 + d]) * sRk[jt] * __expf(glast - sG[jt]));
      }
      const int mt = wave;
      f32x4 a[4];
#pragma unroll
      for (int nt = 0; nt < 4; ++nt) {
        a[nt] = f32x4{0.f, 0.f, 0.f, 0.f};
        if (nt <= mt) {
#pragma unroll
          for (int ks = 0; ks < 4; ++ks)
            a[nt] = mfma16(ldfrag(sQ + (mt * 16 + l15) * 136 + ks * 32 + q * 8),
                           ldfrag(sK + (nt * 16 + l15) * 136 + ks * 32 + q * 8), a[nt]);
        }
      }
#pragma unroll
      for (int nt = 0; nt < 4; ++nt) {
        int jj = nt * 16 + l15;
        float rkj = sRk[jj], gj = sG[jj];
#pragma unroll
        for (int r = 0; r < 4; ++r) {
          int ii = mt * 16 + q * 4 + r;
          float v = 0.f;
          if (ii >= jj) v = a[nt][r] * sRq[ii] * rkj * __expf(sG[ii] - gj);
          sAtt[ii * 72 + jj] = f2bf(v);
        }
      }
    }
    __syncthreads();
    {
      bf16x8 vf[2];
      vf[0] = packfrag(vn[0], vn[1]);
      vf[1] = packfrag(vn[2], vn[3]);
#pragma unroll
      for (int mt = 0; mt < 4; ++mt)
#pragma unroll
        for (int ks = 0; ks < 2; ++ks) oo[mt] = mfma16(ldfrag_perm(sAtt + (mt * 16 + l15) * 72, ks, q), vf[ks], oo[mt]);
      __builtin_amdgcn_sched_barrier(0);
      if (!isctx) {
        bf16_t* gb = gout + (size_t)(b * TT) * 512 + head * 128 + ehalf * 64;
        const int tok0 = rev ? n - 1 - (64 * j + q * 4) : 64 * j + q * 4;
        const int tstep = rev ? -512 : 512;
        unsigned off0 = (unsigned)(tok0 * 512 + wave * 16 + l15);
#pragma unroll
        for (int mt = 0; mt < 4; ++mt)
#pragma unroll
          for (int r = 0; r < 4; ++r) {
            unsigned off = off0 + (unsigned)((mt * 16 + r) * tstep);
            gb[off] = f2bf(oo[mt][r]);
          }
      }
      __builtin_amdgcn_sched_barrier(0);
      const float egl = sEg[63];
#pragma unroll
      for (int m8 = 0; m8 < 8; ++m8) {
#pragma unroll
        for (int r = 0; r < 4; ++r) S[m8][r] *= egl;
#pragma unroll
        for (int ks = 0; ks < 2; ++ks) S[m8] = mfma16(ldfrag_perm(sKdT + (m8 * 16 + l15) * 68, ks, q), vf[ks], S[m8]);
        __builtin_amdgcn_sched_barrier(0);
      }
    }
  }
}

DI void phase_gdn_finalize(const Params& p) {
  const int tid = get_tid();
  const int gid = blockIdx.x * NTHREADS + tid;
  const int nth = gridDim.x * NTHREADS;
  const int l32 = tid & 31;
  for (int w = gid >> 5; w < NLAT * 4; w += nth >> 5) {
    int tok = w >> 2, head = w & 3;
    size_t off = (size_t)tok * 512 + head * 128 + l32 * 4;
    uint2 a = *(const uint2*)(p.gdn_of + off), bq = *(const uint2*)(p.gdn_ob + off);
    float v[4];
    v[0] = __uint_as_float(a.x << 16) + __uint_as_float(bq.x << 16);
    v[1] = __uint_as_float(a.x & 0xffff0000u) + __uint_as_float(bq.x & 0xffff0000u);
    v[2] = __uint_as_float(a.y << 16) + __uint_as_float(bq.y << 16);
    v[3] = __uint_as_float(a.y & 0xffff0000u) + __uint_as_float(bq.y & 0xffff0000u);
    float ss = v[0] * v[0] + v[1] * v[1] + v[2] * v[2] + v[3] * v[3];
#pragma unroll
    for (int o = 16; o >= 1; o >>= 1) ss += __shfl_xor(ss, o);
    float rstd = rsqrtf(ss * (1.f / 128.f) + 1e-6f);
    uint2 zq = *(const uint2*)(p.proj + (size_t)tok * LD1 + 1536 + head * 128 + l32 * 4);
    float z[4] = {__uint_as_float(zq.x << 16), __uint_as_float(zq.x & 0xffff0000u), __uint_as_float(zq.y << 16),
                  __uint_as_float(zq.y & 0xffff0000u)};
    float4 nw = *(const float4*)(p.gdn_norm_w + l32 * 4);
    uint2 o;
    o.x = pack2(v[0] * rstd * nw.x * siluf(z[0]), v[1] * rstd * nw.y * siluf(z[1]));
    o.y = pack2(v[2] * rstd * nw.z * siluf(z[2]), v[3] * rstd * nw.w * siluf(z[3]));
    *(uint2*)(p.mix + (size_t)tok * 1024 + head * 128 + l32 * 4) = o;
  }
}

DI int next_item(unsigned* counter, int* sslot) {
  __syncthreads();
  if (get_tid() == 0) *sslot = (int)atomicAdd(counter, 1u);
  __syncthreads();
  return *sslot;
}

DI void phase_mixer0(const Params& p, char* smem, int rep) {
  int* sslot = (int*)(smem + SMEM_BYTES - 16);
  float lam;
  {
    float s1 = 0.f, s2 = 0.f;
    for (int i = 0; i < 64; ++i) {
      s1 += p.diff_lambda[i] * p.diff_lambda[64 + i];
      s2 += p.diff_lambda[128 + i] * p.diff_lambda[192 + i];
    }
    lam = expf(s1) - expf(s2) + 0.2f;
  }
  const int NH = 256, NDL = NB * 4 * 32, NDC = NB * 4 * 4;
  while (true) {
    int item = next_item(p.counters + 0 + 2 * rep, sslot);
    if (item >= NH + NDL + NDC) break;
    if (item < NH) {
      hgrn_item(p, smem, item >> 3, item & 7);
    } else if (item < NH + NDL) {
      int i = item - NH;
      diff_item(p, smem, i >> 7, (i >> 5) & 3, i & 31, false, lam);
    } else {
      int i = item - NH - NDL;
      diff_item(p, smem, i >> 4, (i >> 2) & 3, i & 3, true, lam);
    }
  }
}

DI void phase_mixer1(const Params& p, char* smem, int rep) {
  int* sslot = (int*)(smem + SMEM_BYTES - 16);
  const int NG = 512, NS = NB * 8 * 32;
  while (true) {
    int item = next_item(p.counters + 1 + 2 * rep, sslot);
    if (item >= NG + NS) break;
    if (item < NG) {
      gdn_item(p, smem, item >> 4, (item >> 2) & 3, (item >> 1) & 1, item & 1);
    } else {
      int i = item - NG;
      swa_item(p, smem, i >> 8, (i >> 5) & 7, i & 31);
    }
  }
}

DI int quad_sum_i(int c) { return rows_sum_i(c); }
DI float quad_max_f(float v) { return rows_max(v); }
DI float quad_min_f(float v) { return rows_min(v); }
template <int NV>
DI float bisect16(const float (&v)[NV], float lo, float hi) {
  bool done = false;
  float tau = hi;
  for (int it = 0; it < 48; ++it) {
    float mid = 0.5f * (lo + hi);
    int c = 0;
#pragma unroll
    for (int k = 0; k < NV; ++k) c += (v[k] > mid) ? 1 : 0;
    c = quad_sum_i(c);
    if (!done) {
      if (c == 16) {
        done = true;
        tau = mid;
      } else if (c > 16) lo = mid;
      else hi = mid;
      if (!done) tau = hi;
    }
    if (__ballot(!done) == 0ull) break;
  }
  return tau;
}

DI void phase_topk(const Params& p, char* smem, int layer, int ntok) {
  const int tid0 = get_tid();
  const int nunits = (ntok / 16) * 2;
  for (int unit = blockIdx.x * 4 + (tid0 >> 6); unit < nunits; unit += gridDim.x * 4) {
    const int tok0 = (unit >> 1) * 16, hh = unit & 1;
    for (int h = hh * 4; h < hh * 4 + 4; ++h) {
      int tid = tid0;
      asm volatile("" : "+v"(tid));
      const int lane = tid & 63, wave = tid >> 6, q = lane >> 4, l15 = lane & 15;
      float* selV = (float*)smem + wave * 1536;
      int* selI = (int*)(selV + 512);
      float* outV = selV + 1024;
      int* outI = (int*)(selV + 1280);
      {
        f32x4 ninf = f32x4{-INFINITY, -INFINITY, -INFINITY, -INFINITY};
        u32x4 z = u32x4{0u, 0u, 0u, 0u};
        *(f32x4*)(selV + (l15 * 16) + q * 4) = ninf;
        *(f32x4*)(selV + 256 + (l15 * 16) + q * 4) = ninf;
        *(u32x4*)(selI + (l15 * 16) + q * 4) = z;
        *(u32x4*)(selI + 256 + (l15 * 16) + q * 4) = z;
        *(f32x4*)(outV + (l15 * 16) + q * 4) = ninf;
        *(u32x4*)(outI + (l15 * 16) + q * 4) = z;
      }
      float mx12[2], mn12[2];
#pragma unroll
      for (int pp = 0; pp < 2; ++pp) {
        const float* sp = p.pq + (size_t)(tok0 + l15) * 2048 + h * 256 + pp * 128 + q * 32;
        f32x4 sw[8];
#pragma unroll
        for (int i = 0; i < 8; ++i) sw[i] = *(const f32x4*)(sp + i * 4);
        float v[32];
        float mx = -INFINITY, mn = INFINITY;
#pragma unroll
        for (int i = 0; i < 8; ++i)
#pragma unroll
          for (int k = 0; k < 4; ++k) {
            v[i * 4 + k] = sw[i][k];
            mx = fmaxf(mx, sw[i][k]);
            mn = fminf(mn, sw[i][k]);
          }
        mx = quad_max_f(mx);
        mn = quad_min_f(mn);
        float tau = bisect16<32>(v, mn - 1.f, mx);
        int cl = 0;
#pragma unroll
        for (int k = 0; k < 32; ++k) cl += (v[k] > tau) ? 1 : 0;
        int c0 = __shfl(cl, l15), c1 = __shfl(cl, l15 + 16), c2 = __shfl(cl, l15 + 32);
        int slot = (q > 0 ? c0 : 0) + (q > 1 ? c1 : 0) + (q > 2 ? c2 : 0);
        float smin = INFINITY;
#pragma unroll
        for (int k = 0; k < 32; ++k) {
          if (v[k] > tau) {
            int sl = slot < 15 ? slot : 15;
            selV[pp * 256 + l15 * 16 + sl] = v[k];
            selI[pp * 256 + l15 * 16 + sl] = q * 32 + k;
            smin = fminf(smin, v[k]);
            slot++;
          }
        }
        mx12[pp] = mx;
        mn12[pp] = quad_min_f(smin);
      }
      __builtin_amdgcn_fence(__ATOMIC_RELEASE, "wavefront");
      __builtin_amdgcn_wave_barrier();
      float cand[64];
      int ai[4];
      {
        f32x4 a4 = *(const f32x4*)(selV + l15 * 16 + q * 4);
        u32x4 ai4 = *(const u32x4*)(selI + l15 * 16 + q * 4);
#pragma unroll
        for (int ii = 0; ii < 4; ++ii) ai[ii] = (int)ai4[ii];
#pragma unroll
        for (int j4 = 0; j4 < 4; ++j4) {
          f32x4 b4 = *(const f32x4*)(selV + 256 + l15 * 16 + j4 * 4);
#pragma unroll
          for (int ii = 0; ii < 4; ++ii)
#pragma unroll
            for (int jj = 0; jj < 4; ++jj) cand[ii * 16 + j4 * 4 + jj] = a4[ii] + b4[jj];
        }
      }
      const float m2 = mx12[0] + mx12[1];
      float lo2 = mn12[0] + mn12[1] - 1.f;
      if (!(lo2 > -1e30f)) lo2 = -1e30f;
      float tau2 = bisect16<64>(cand, lo2, m2);
      {
        int cl = 0;
#pragma unroll
        for (int k = 0; k < 64; ++k) cl += (cand[k] > tau2) ? 1 : 0;
        int c0 = __shfl(cl, l15), c1 = __shfl(cl, l15 + 16), c2 = __shfl(cl, l15 + 32);
        int slot = (q > 0 ? c0 : 0) + (q > 1 ? c1 : 0) + (q > 2 ? c2 : 0);
#pragma unroll
        for (int k = 0; k < 64; ++k) {
          if (cand[k] > tau2) {
            int sl = slot < 15 ? slot : 15;
            outV[l15 * 16 + sl] = cand[k];
            outI[l15 * 16 + sl] = ai[k >> 4] * 128 + selI[256 + l15 * 16 + (k & 15)];
            slot++;
          }
        }
      }
      __builtin_amdgcn_fence(__ATOMIC_RELEASE, "wavefront");
      __builtin_amdgcn_wave_barrier();
      {
        f32x4 v4 = *(const f32x4*)(outV + l15 * 16 + q * 4);
        u32x4 i4 = *(const u32x4*)(outI + l15 * 16 + q * 4);
        f32x4 e4;
        float ssum = 0.f;
#pragma unroll
        for (int k = 0; k < 4; ++k) {
          e4[k] = expf(v4[k] - m2);
          ssum += e4[k];
        }
        ssum = rows_sum(ssum);
        float inv = 1.f / ssum;
#pragma unroll
        for (int k = 0; k < 4; ++k) e4[k] *= inv;
        size_t o = (size_t)(tok0 + l15) * 128 + h * 16 + q * 4;
        *(u32x4*)(p.pidx + o) = i4;
        *(f32x4*)(p.pgate + o) = e4;
      }
      __builtin_amdgcn_wave_barrier();
    }
  }
}

DI void phase_experts_u(const Params& p, int layer, int ntok) {
  const int lane = get_tid() & 63, wave = get_tid() >> 6;
  const unsigned char* ub = p.u_q + (size_t)layer * 16384 * 1024;
  const float* usc = p.u_sc + layer * 16384;
  const float* vsc = p.v_sc + layer * 16384;
  for (int tok = blockIdx.x * 4 + wave; tok < ntok; tok += gridDim.x * 4) {
    const bf16_t* hrow = p.mix + (size_t)tok * 1024 + lane * 16;
    u32x4 xa = *(const u32x4*)hrow, xb = *(const u32x4*)(hrow + 8);
    float xf[16];
    float xs = 0.f;
#pragma unroll
    for (int k = 0; k < 4; ++k) {
      xf[2 * k] = __uint_as_float(xa[k] << 16);
      xf[2 * k + 1] = __uint_as_float(xa[k] & 0xffff0000u);
      xf[8 + 2 * k] = __uint_as_float(xb[k] << 16);
      xf[8 + 2 * k + 1] = __uint_as_float(xb[k] & 0xffff0000u);
    }
#pragma unroll
    for (int k = 0; k < 16; ++k) xs += xf[k];
    const float XS128 = 128.f * wave_sum(xs);
    int i0 = p.pidx[(size_t)tok * 128 + lane], i1 = p.pidx[(size_t)tok * 128 + 64 + lane];
    float g0 = p.pgate[(size_t)tok * 128 + lane], g1 = p.pgate[(size_t)tok * 128 + 64 + lane];
    constexpr int EU = 16;
    for (int e = 0; e < 128; e += EU) {
      u32x4 uq[EU];
#pragma unroll
      for (int u = 0; u < EU; ++u) {
        int ee = e + u;
        int row = __builtin_amdgcn_readlane(ee < 64 ? i0 : i1, ee & 63);
        uq[u] = *(const u32x4*)(ub + (size_t)row * 1024 + lane * 16);
      }
      const int esel = e + (lane & (EU - 1));
      const int myrow = __shfl(esel < 64 ? i0 : i1, esel & 63);
      const float mygate = __shfl(esel < 64 ? g0 : g1, esel & 63);
      const float mysu = usc[myrow], mysv = vsc[myrow];
      float d[EU];
#pragma unroll
      for (int u = 0; u < EU; ++u) {
        float sacc = 0.f;
#pragma unroll
        for (int k = 0; k < 4; ++k) {
          unsigned w = uq[u][k];
          sacc += xf[4 * k] * (float)(w & 0xffu);
          sacc += xf[4 * k + 1] * (float)((w >> 8) & 0xffu);
          sacc += xf[4 * k + 2] * (float)((w >> 16) & 0xffu);
          sacc += xf[4 * k + 3] * (float)(w >> 24);
        }
        d[u] = wave_sum(sacc);
      }
      float dsel = d[0];
#pragma unroll
      for (int u = 1; u < EU; ++u) dsel = ((lane & (EU - 1)) == u) ? d[u] : dsel;
      const float xd = mysu * (dsel - XS128);
      const float c2l = mygate * 0.5f * xd * (1.f + erff(xd * 0.7071067811865476f)) * mysv;
      if (lane < EU) p.pgate[(size_t)tok * 128 + e + lane] = c2l;
    }
  }
}

DI void phase_experts(const Params& p, int layer, int ntok, int dry) {
  const int lane = get_tid() & 63, wave = get_tid() >> 6;
  const unsigned char* vb = p.v_q + (size_t)layer * 16384 * 1024;
  for (int tok = blockIdx.x * 4 + wave; tok < ntok; tok += gridDim.x * 4) {
    int i0 = p.pidx[(size_t)tok * 128 + lane], i1 = p.pidx[(size_t)tok * 128 + 64 + lane];
    float g0 = p.pgate[(size_t)tok * 128 + lane], g1 = p.pgate[(size_t)tok * 128 + 64 + lane];
    float acc[16];
#pragma unroll
    for (int k = 0; k < 16; ++k) acc[k] = 0.f;
    float csum = 0.f;
    constexpr int EU = 16;
    for (int e = 0; e < 128; e += EU) {
      u32x4 vq[EU];
      float c2s[EU];
#pragma unroll
      for (int u = 0; u < EU; ++u) {
        int ee = e + u;
        int row = __builtin_amdgcn_readlane(ee < 64 ? i0 : i1, ee & 63);
        c2s[u] = __uint_as_float(__builtin_amdgcn_readlane(__float_as_uint(ee < 64 ? g0 : g1), ee & 63));
        vq[u] = *(const u32x4*)(vb + (size_t)row * 1024 + lane * 16);
      }
#pragma unroll
      for (int u = 0; u < EU; ++u) {
        const float c2 = c2s[u];
        csum += c2;
#pragma unroll
        for (int k = 0; k < 4; ++k) {
          unsigned w = vq[u][k];
          acc[4 * k] += c2 * (float)(w & 0xffu);
          acc[4 * k + 1] += c2 * (float)((w >> 8) & 0xffu);
          acc[4 * k + 2] += c2 * (float)((w >> 16) & 0xffu);
          acc[4 * k + 3] += c2 * (float)(w >> 24);
        }
      }
    }
#pragma unroll
    for (int k = 0; k < 16; ++k) acc[k] -= 128.f * csum;
    int vec = vec_of_row(tok);
    float* xr = tok < NLAT ? p.out + (size_t)tok * 1024 : p.xc + (size_t)(tok - NLAT) * 1024;
    const float* g2 = modp(p, layer, vec, 5);
    float xn[16];
    float ss = 0.f;
#pragma unroll
    for (int hlf = 0; hlf < 2; ++hlf) {
      int c0 = lane * 16 + hlf * 8;
      float4 a = *(const float4*)(xr + c0), bq = *(const float4*)(xr + c0 + 4);
      float4 ga = *(const float4*)(g2 + c0), gb = *(const float4*)(g2 + c0 + 4);
      float* o = xn + hlf * 8;
      o[0] = a.x + ga.x * acc[hlf * 8 + 0];
      o[1] = a.y + ga.y * acc[hlf * 8 + 1];
      o[2] = a.z + ga.z * acc[hlf * 8 + 2];
      o[3] = a.w + ga.w * acc[hlf * 8 + 3];
      o[4] = bq.x + gb.x * acc[hlf * 8 + 4];
      o[5] = bq.y + gb.y * acc[hlf * 8 + 5];
      o[6] = bq.z + gb.z * acc[hlf * 8 + 6];
      o[7] = bq.w + gb.w * acc[hlf * 8 + 7];
#pragma unroll
      for (int k = 0; k < 8; ++k) ss += o[k] * o[k];
    }
    ss = wave_sum(ss);
    float rstd = rsqrtf(ss * (1.f / 1024.f) + 1e-6f);
    if (dry && ss != -1.f) continue;
    if (layer == 0) {
      const float* nw = p.norm_w + (1 * 2 + 0) * 1024;
      const float* sh = modp(p, 1, vec, 0);
      const float* sc = modp(p, 1, vec, 1);
#pragma unroll
      for (int hlf = 0; hlf < 2; ++hlf) {
        int c0 = lane * 16 + hlf * 8;
        float* o = xn + hlf * 8;
        *(float4*)(xr + c0) = float4{o[0], o[1], o[2], o[3]};
        *(float4*)(xr + c0 + 4) = float4{o[4], o[5], o[6], o[7]};
        float hv[8];
#pragma unroll
        for (int k = 0; k < 8; ++k) hv[k] = o[k] * rstd * nw[c0 + k] * (1.f + sc[c0 + k]) + sh[c0 + k];
        uint4 w;
        w.x = pack2(hv[0], hv[1]);
        w.y = pack2(hv[2], hv[3]);
        w.z = pack2(hv[4], hv[5]);
        w.w = pack2(hv[6], hv[7]);
        *(uint4*)(p.mix + (size_t)tok * 1024 + c0) = w;
      }
    } else {
      const float* fw = p.final_norm_w;
#pragma unroll
      for (int hlf = 0; hlf < 2; ++hlf) {
        int c0 = lane * 16 + hlf * 8;
        float* o = xn + hlf * 8;
        float4 w0 = *(const float4*)(fw + c0), w1 = *(const float4*)(fw + c0 + 4);
        *(float4*)(xr + c0) = float4{o[0] * rstd * w0.x, o[1] * rstd * w0.y, o[2] * rstd * w0.z, o[3] * rstd * w0.w};
        *(float4*)(xr + c0 + 4) = float4{o[4] * rstd * w1.x, o[5] * rstd * w1.y, o[6] * rstd * w1.z, o[7] * rstd * w1.w};
      }
    }
  }
}

DI void run_phase(const Params& p, int ph, char* smem, int rep = 0) {
  switch (ph) {
    case 0: phase_setup(p, smem); break;
    case 1: phase_modulate(p, p.x, p.ctx, NTOK, 0, 0); break;
    case 2: phase_gemm<EPI_IN0>(p, p.mix, p.wt_in0, NTOK, 4096, smem, 0, nullptr, nullptr); break;
    case 3: phase_mixer0(p, smem, rep); break;
    case 4: phase_gemm<EPI_OUT>(p, p.mix, p.wt_out0, NTOK, 1024, smem, 0, p.x, p.ctx, rep); break;
    case 5: phase_modulate(p, p.out, p.xc, NTOK, 0, 1); break;
    case 6: phase_gemm<EPI_PQ>(p, p.mix, p.wt_q, NTOK, 2048, smem, 0, nullptr, nullptr); break;
    case 7: phase_topk(p, smem, 0, NTOK); break;
    case 8: phase_experts_u(p, 0, NTOK); break;
    case 9: phase_experts(p, 0, NTOK, rep); break;
    case 10: phase_gemm<EPI_IN1>(p, p.mix, p.wt_in1, NTOK, 2944, smem, 1, nullptr, nullptr); break;
    case 11: phase_mixer1(p, smem, rep); break;
    case 12: phase_gdn_finalize(p); break;
    case 13: phase_gemm<EPI_OUT>(p, p.mix, p.wt_out1, NLAT, 1024, smem, 1, p.out, p.xc, rep); break;
    case 14: phase_modulate(p, p.out, p.xc, NLAT, 1, 1); break;
    case 15: phase_gemm<EPI_PQ>(p, p.mix, p.wt_q + (size_t)2048 * 1024, NLAT, 2048, smem, 1, nullptr, nullptr); break;
    case 16: phase_topk(p, smem, 1, NLAT); break;
    case 17: phase_experts_u(p, 1, NLAT); break;
    case 18: phase_experts(p, 1, NLAT, rep); break;
  }
}

#if SINGLE_LAUNCH
__global__ void __launch_bounds__(NTHREADS, 2) mega_kernel(Params p, int ph_lo, int ph_hi) {
  __shared__ __attribute__((aligned(16))) char smem[SMEM_BYTES];
#ifdef PROBE_A
  unsigned long long* tstamp = (unsigned long long*)(p.counters + 16);
#endif
  for (int ph = ph_lo; ph < ph_hi; ++ph) {
    if (ph > ph_lo) cg::this_grid().sync();
#ifdef PROBE_A
    if (blockIdx.x == 0 && threadIdx.x == 0) tstamp[ph] = wall_clock64();
#endif
    run_phase(p, ph, smem);
#ifdef REPEAT_MASK
    if ((REPEAT_MASK >> ph) & 1) {
      cg::this_grid().sync();
      run_phase(p, ph, smem, 1);
    }
#endif
  }
#ifdef PROBE_A
  cg::this_grid().sync();
  if (blockIdx.x == 0) {
    if (threadIdx.x == 0) tstamp[NPHASES] = wall_clock64();
    __syncthreads();
    float A = 0.f, B = 0.f;
    for (int ph = 0; ph < NPHASES; ++ph) {
      float d = (float)(tstamp[ph + 1] - tstamp[ph]) * 0.01f;
      if ((PROBE_A >> ph) & 1) A += d;
      if ((PROBE_B >> ph) & 1) B += d;
    }
    for (int i = threadIdx.x; i < 65536; i += NTHREADS) p.out[1024 + i] += B;
    if (threadIdx.x == 0) p.out[0] += A;
  }
#endif
}
#define OCC_KERNEL mega_kernel
#else
template <int PH>
__global__ void __launch_bounds__(NTHREADS, (PH == 10 ? 1 : 2)) phase_kernel(Params p) {
  __shared__ __attribute__((aligned(16))) char smem[SMEM_BYTES];
  run_phase(p, PH, smem);
}
#define OCC_KERNEL phase_kernel<3>
template <int PH>
static void launch_phases(const Params& p, int grid, hipStream_t stream) {
  hipLaunchKernelGGL(phase_kernel<PH>, dim3(grid), dim3(NTHREADS), 0, stream, p);
  if constexpr (PH + 1 < NPHASES) launch_phases<PH + 1>(p, grid, stream);
}
#endif

extern "C" void kernel_launch(void* const* d_in, const int* in_sizes, int n_in, void* d_out, int out_size, void* d_ws,
                              size_t ws_size, hipStream_t stream) {
  static int grid_blocks = 0;
  if (!grid_blocks) {
    int dev = 0, cus = 0, per_cu = 0;
    (void)hipGetDevice(&dev);
    (void)hipDeviceGetAttribute(&cus, hipDeviceAttributeMultiprocessorCount, dev);
    (void)hipOccupancyMaxActiveBlocksPerMultiprocessor(&per_cu, OCC_KERNEL, NTHREADS, 0);
    if (per_cu < 1) per_cu = 1;
    if (per_cu > 2) per_cu = 2;
    grid_blocks = cus * per_cu;
  }
  Params p{};
  const float** fp = (const float**)&p;
  for (int i = 0; i < 25; ++i) fp[i] = (const float*)d_in[i];
  p.out = (float*)d_out;
  char* ws = (char*)d_ws;
  size_t off = 0;
  auto take = [&](size_t bytes) { char* r = ws + off; off += (bytes + 255) & ~(size_t)255; return r; };
  p.proj = (bf16_t*)take((size_t)NTOK * LD0 * 2);
  p.mix = (bf16_t*)take((size_t)NTOK * 1024 * 2);
  p.xc = (float*)take((size_t)NCTX * 1024 * 4);
  p.mod = (float*)take((size_t)2 * 33 * 6144 * 4);
  p.rope = (float*)take(64 * 16 * 2 * 4);
  p.wt_in0 = (bf16_t*)take((size_t)4096 * 1024 * 2);
  p.wt_out0 = (bf16_t*)take((size_t)1024 * 1024 * 2);
  p.wt_in1 = (bf16_t*)take((size_t)2944 * 1024 * 2);
  p.wt_out1 = (bf16_t*)take((size_t)1024 * 1024 * 2);
  p.wt_q = (bf16_t*)take((size_t)2 * 2048 * 1024 * 2);
  p.keys_bf = (bf16_t*)take((size_t)2 * 8 * 2 * 128 * 128 * 2);
  p.u_q = (unsigned char*)take((size_t)2 * 16384 * 1024);
  p.v_q = (unsigned char*)take((size_t)2 * 16384 * 1024);
  p.u_sc = (float*)take((size_t)2 * 16384 * 4);
  p.v_sc = (float*)take((size_t)2 * 16384 * 4);
  p.counters = (unsigned*)take(256);
  p.pq = (float*)p.proj;
  p.pidx = (int*)take((size_t)NTOK * 128 * 4);
  p.pgate = (float*)take((size_t)NTOK * 128 * 4);
  p.gdn_of = (bf16_t*)((char*)p.proj + (size_t)NTOK * LD1 * 2);
  p.gdn_ob = p.gdn_of + (size_t)NLAT * 512;
  if (off > ws_size) fprintf(stderr, "workspace too small: need %zu have %zu\n", off, ws_size);
  (void)hipMemsetAsync(p.counters, 0, 256, stream);
#if SINGLE_LAUNCH
  int lo = 0, hi = NPHASES;
  void* args[] = {&p, &lo, &hi};
  hipError_t e = hipLaunchCooperativeKernel((void*)mega_kernel, dim3(grid_blocks), dim3(NTHREADS), args, 0, stream);
  if (e != hipSuccess) fprintf(stderr, "cooperative launch failed: %s (grid %d)\n", hipGetErrorString(e), grid_blocks);
#else
  launch_phases<0>(p, grid_blocks, stream);
#endif
}
```

```cpp
#include <hip/hip_runtime.h>
#include <hip/hip_cooperative_groups.h>
#include <cstdio>
#include <type_traits>
namespace cg = cooperative_groups;

#ifndef SINGLE_LAUNCH
#define SINGLE_LAUNCH 1
#endif

typedef unsigned short bf16_t;
using bf16x8 = __attribute__((ext_vector_type(8))) short;
using s16x4 = __attribute__((ext_vector_type(4))) short;
using f32x4 = __attribute__((ext_vector_type(4))) float;
using u32x4 = __attribute__((ext_vector_type(4))) unsigned;
typedef __attribute__((ext_vector_type(2))) __bf16 bf2_t;
#define DI __device__ __forceinline__

constexpr int NB = 32, TT = 2048, LL = 256, DM = 1024;
constexpr int NLAT = NB * TT, NCTX = NB * LL, NTOK = NLAT + NCTX;
constexpr int LD0 = 4096, LD1 = 2944;
constexpr int SMEM_BYTES = 79360;
constexpr int NTHREADS = 256;
constexpr int NPHASES = 19;

struct Params {
  const float *x, *c, *ctx, *c_ctx, *ada_w, *ada_b, *norm_w, *final_norm_w, *even_w_in, *even_w_out, *diff_lambda,
      *diff_subln_w, *hgrn_lb, *hgrn_norm_w, *odd_w_in, *odd_w_out, *gdn_conv_w, *gdn_a_log, *gdn_dt_bias, *gdn_norm_w,
      *swa_sink, *peer_w_q, *peer_keys, *peer_u, *peer_v;
  float* out;
  bf16_t *proj, *mix, *wt_in0, *wt_out0, *wt_in1, *wt_out1, *wt_q, *keys_bf, *gdn_of, *gdn_ob;
  float* pq;
  unsigned char *u_q, *v_q;
  float *u_sc, *v_sc;
  float *xc, *mod, *rope, *pgate;
  int* pidx;
  unsigned* counters;
  unsigned* xbar;
};

DI int get_tid() {
  int t = threadIdx.x;
  asm volatile("" : "+v"(t));
  return t;
}
DI bf16_t f2bf(float x) { return __builtin_bit_cast(unsigned short, (__bf16)x); }
DI float bf2f(bf16_t h) { return __uint_as_float(((unsigned)h) << 16); }
DI unsigned pack2(float a, float b) {
  typedef __attribute__((ext_vector_type(2))) float f32x2_t;
  f32x2_t v = {a, b};
  return __builtin_bit_cast(unsigned, __builtin_convertvector(v, bf2_t));
}
DI f32x4 mfma16(bf16x8 a, bf16x8 b, f32x4 c) { return __builtin_amdgcn_mfma_f32_16x16x32_bf16(a, b, c, 0, 0, 0); }
DI bf16x8 ldfrag(const bf16_t* p) { return *(const bf16x8*)p; }
DI bf16x8 ldfrag_perm(const bf16_t* row, int ks, int q) {
  s16x4 lo = *(const s16x4*)(row + ks * 32 + q * 4);
  s16x4 hi = *(const s16x4*)(row + ks * 32 + 16 + q * 4);
  return __builtin_shufflevector(lo, hi, 0, 1, 2, 3, 4, 5, 6, 7);
}
DI bf16x8 packfrag(f32x4 a, f32x4 b) {
  unsigned w0 = pack2(a[0], a[1]), w1 = pack2(a[2], a[3]), w2 = pack2(b[0], b[1]), w3 = pack2(b[2], b[3]);
  typedef __attribute__((ext_vector_type(4))) unsigned u32x4;
  u32x4 v = {w0, w1, w2, w3};
  return __builtin_bit_cast(bf16x8, v);
}
DI float siluf(float x) { return x / (1.f + expf(-x)); }
DI float silu_fast(float x) { return __fdividef(x, 1.f + __expf(-x)); }
DI float sigmoidf_(float x) { return 1.f / (1.f + expf(-x)); }
template <int N>
DI float dpp_ror(float v) {
  return __builtin_bit_cast(float, __builtin_amdgcn_update_dpp(0, __builtin_bit_cast(int, v), 0x120 + N, 0xf, 0xf, false));
}
DI float grp16_sum(float v) {
  v += dpp_ror<8>(v);
  v += dpp_ror<4>(v);
  v += dpp_ror<2>(v);
  v += dpp_ror<1>(v);
  return v;
}
DI float grp16_max(float v) {
  v = fmaxf(v, dpp_ror<8>(v));
  v = fmaxf(v, dpp_ror<4>(v));
  v = fmaxf(v, dpp_ror<2>(v));
  v = fmaxf(v, dpp_ror<1>(v));
  return v;
}
DI float rows_sum(float v) {
  auto a = __builtin_amdgcn_permlane16_swap(__float_as_uint(v), __float_as_uint(v), false, false);
  v = __uint_as_float(a[0]) + __uint_as_float(a[1]);
  auto b = __builtin_amdgcn_permlane32_swap(__float_as_uint(v), __float_as_uint(v), false, false);
  return __uint_as_float(b[0]) + __uint_as_float(b[1]);
}
DI float rows_max(float v) {
  auto a = __builtin_amdgcn_permlane16_swap(__float_as_uint(v), __float_as_uint(v), false, false);
  v = fmaxf(__uint_as_float(a[0]), __uint_as_float(a[1]));
  auto b = __builtin_amdgcn_permlane32_swap(__float_as_uint(v), __float_as_uint(v), false, false);
  return fmaxf(__uint_as_float(b[0]), __uint_as_float(b[1]));
}
DI float rows_min(float v) {
  auto a = __builtin_amdgcn_permlane16_swap(__float_as_uint(v), __float_as_uint(v), false, false);
  v = fminf(__uint_as_float(a[0]), __uint_as_float(a[1]));
  auto b = __builtin_amdgcn_permlane32_swap(__float_as_uint(v), __float_as_uint(v), false, false);
  return fminf(__uint_as_float(b[0]), __uint_as_float(b[1]));
}
DI int rows_sum_i(int v) {
  auto a = __builtin_amdgcn_permlane16_swap((unsigned)v, (unsigned)v, false, false);
  v = (int)(a[0] + a[1]);
  auto b = __builtin_amdgcn_permlane32_swap((unsigned)v, (unsigned)v, false, false);
  return (int)(b[0] + b[1]);
}
DI float wave_sum(float v) { return rows_sum(grp16_sum(v)); }
DI const float* modp(const Params& p, int layer, int vec, int chunk) {
  return p.mod + ((size_t)(layer * 33 + vec) * 6 + chunk) * 1024;
}
DI int vec_of_row(int row) { return row < NLAT ? (row >> 11) : 32; }

DI void transpose_job(const float* W, int nsrc, bf16_t* Wt, int n0, int k0, int mapmode, float* tile) {
  const int tid = get_tid();
  __syncthreads();
#pragma unroll 4
  for (int i = 0; i < 16; ++i) {
    int kk = (tid >> 6) + 4 * i, nn = tid & 63;
    int nd = n0 + nn, ns = nd;
    if (mapmode == 1) ns = nd < 2048 ? nd : (nd < 2816 ? nd + 16 : (nd < 2832 ? nd - 768 : -1));
    float v = ns >= 0 ? W[(size_t)(k0 + kk) * nsrc + ns] : 0.f;
    tile[kk * 65 + nn] = v;
  }
  __syncthreads();
#pragma unroll 4
  for (int i = 0; i < 16; ++i) {
    int nn = (tid >> 6) + 4 * i, kk = tid & 63;
    Wt[(size_t)(n0 + nn) * 1024 + k0 + kk] = f2bf(tile[kk * 65 + nn]);
  }
}

DI void convert_seg(const float* src, bf16_t* dst, size_t n4) {
  size_t stride = (size_t)gridDim.x * NTHREADS;
  for (size_t i = (size_t)blockIdx.x * NTHREADS + get_tid(); i < n4; i += stride) {
    float4 v = ((const float4*)src)[i];
    uint2 o;
    o.x = pack2(v.x, v.y);
    o.y = pack2(v.z, v.w);
    ((uint2*)dst)[i] = o;
  }
}

DI int setup_next_item(unsigned* counter, int* sslot) {
  __syncthreads();
  if (get_tid() == 0) *sslot = (int)atomicAdd(counter, 1u);
  __syncthreads();
  return *sslot;
}

DI void phase_setup(const Params& p, char* smem) {
  const int tid = get_tid();
  float* sm = (float*)smem;
  int* sslot = (int*)(smem + SMEM_BYTES - 16);
  for (int i = blockIdx.x * NTHREADS + tid; i < 64 * 16; i += gridDim.x * NTHREADS) {
    int pos = i >> 4, f = i & 15;
    float inv = powf(10000.f, -(float)f / 16.f);
    float ang = (float)pos * inv;
    p.rope[i * 2] = cosf(ang);
    p.rope[i * 2 + 1] = sinf(ang);
  }
  const int NA = 192, J0 = 1024, J1 = J0 + 256, J2 = J1 + 736, J3 = J2 + 256, J4 = J3 + 512, NQI = 2048;
  while (true) {
    const int item = setup_next_item(p.counters + 8, sslot);
    if (item >= NA + J4 + NQI) break;
    if (item < NA) {
      const int job = item;
    int layer = job / 96, col0 = (job % 96) * 64;
    float acc[33];
#pragma unroll
    for (int v = 0; v < 33; ++v) acc[v] = 0.f;
    float* sc = sm;
    float* red = sm + 33 * 256;
    const int col = col0 + (tid & 63), kq = tid >> 6;
    for (int kc = 0; kc < 4; ++kc) {
      __syncthreads();
      for (int idx = tid; idx < 33 * 256; idx += NTHREADS) {
        int v = idx >> 8, kk = idx & 255, k = kc * 256 + kk;
        float cv = v < 32 ? p.c[v * 1024 + k] : p.c_ctx[k];
        sc[idx] = siluf(cv);
      }
      __syncthreads();
#pragma unroll 8
      for (int kk = kq * 64; kk < kq * 64 + 64; ++kk) {
        float w = p.ada_w[((size_t)layer * 1024 + kc * 256 + kk) * 6144 + col];
#pragma unroll
        for (int v = 0; v < 33; ++v) acc[v] += sc[v * 256 + kk] * w;
      }
    }
    __syncthreads();
#pragma unroll
    for (int v = 0; v < 33; ++v) red[(kq * 33 + v) * 64 + (tid & 63)] = acc[v];
    __syncthreads();
    for (int idx = tid; idx < 33 * 64; idx += NTHREADS) {
      int v = idx >> 6, cc = idx & 63;
      float s = p.ada_b[layer * 6144 + col0 + cc];
#pragma unroll
      for (int k4 = 0; k4 < 4; ++k4) s += red[(k4 * 33 + v) * 64 + cc];
      p.mod[(size_t)(layer * 33 + v) * 6144 + col0 + cc] = s;
    }
    __syncthreads();
    } else if (item < NA + J4) {
      const int job = item - NA;
      if (job < J0) {
        transpose_job(p.even_w_in, 4096, p.wt_in0, (job >> 4) * 64, (job & 15) * 64, 0, sm);
      } else if (job < J1) {
        int j = job - J0;
        transpose_job(p.even_w_out, 1024, p.wt_out0, (j >> 4) * 64, (j & 15) * 64, 0, sm);
      } else if (job < J2) {
        int j = job - J1;
        transpose_job(p.odd_w_in, 2832, p.wt_in1, (j >> 4) * 64, (j & 15) * 64, 1, sm);
      } else if (job < J3) {
        int j = job - J2;
        transpose_job(p.odd_w_out, 1024, p.wt_out1, (j >> 4) * 64, (j & 15) * 64, 0, sm);
      } else {
        int j = job - J3;
        const int layer = j >> 8, hp = (j >> 4) & 15, kt = j & 15;
        const int lane = tid & 63, wave = tid >> 6, q = lane >> 4, l15 = lane & 15;
        const float* wq = p.peer_w_q + ((size_t)layer * 1024 + kt * 64 + wave * 16 + l15) * 2048 + hp * 128;
        const float* ky = p.peer_keys + ((size_t)(layer * 16 + hp) * 128) * 128;
        f32x4 acc[8];
#pragma unroll
        for (int nt = 0; nt < 8; ++nt) acc[nt] = f32x4{0.f, 0.f, 0.f, 0.f};
#pragma unroll
        for (int ks = 0; ks < 4; ++ks) {
          f32x4 a0 = *(const f32x4*)(wq + ks * 32 + q * 8), a1 = *(const f32x4*)(wq + ks * 32 + q * 8 + 4);
          bf16x8 af = packfrag(a0, a1);
#pragma unroll
          for (int nt = 0; nt < 8; ++nt) {
            const float* kp = ky + (size_t)(nt * 16 + l15) * 128 + ks * 32 + q * 8;
            f32x4 b0 = *(const f32x4*)kp, b1 = *(const f32x4*)(kp + 4);
            acc[nt] = mfma16(af, packfrag(b0, b1), acc[nt]);
          }
        }
#pragma unroll
        for (int nt = 0; nt < 8; ++nt) {
          uint2 ov;
          ov.x = pack2(acc[nt][0], acc[nt][1]);
          ov.y = pack2(acc[nt][2], acc[nt][3]);
          *(uint2*)(p.wt_q + (size_t)layer * 2048 * 1024 + (size_t)(hp * 128 + nt * 16 + l15) * 1024 + kt * 64 + wave * 16 + q * 4) = ov;
        }
      }
    } else {
      const int lane = tid & 63, wave = tid >> 6;
      const int row0 = (item - NA - J4) * 32 + wave * 8;
#pragma unroll 1
      for (int rb = 0; rb < 8; rb += 4) {
        f32x4 v[4][4];
#pragma unroll
        for (int rr = 0; rr < 4; ++rr) {
          const int row = row0 + rb + rr;
          const int tab = row >> 15, r = row & 32767;
          const float* src = (tab == 0 ? p.peer_u : p.peer_v) + (size_t)r * 1024 + lane * 16;
#pragma unroll
          for (int i = 0; i < 4; ++i) v[rr][i] = *(const f32x4*)(src + i * 4);
        }
#pragma unroll
        for (int rr = 0; rr < 4; ++rr) {
          const int row = row0 + rb + rr;
          const int tab = row >> 15, r = row & 32767;
          float mx = 0.f;
#pragma unroll
          for (int i = 0; i < 4; ++i)
#pragma unroll
            for (int k = 0; k < 4; ++k) mx = fmaxf(mx, fabsf(v[rr][i][k]));
          mx = rows_max(grp16_max(mx));
          float sc = mx > 0.f ? mx * (1.f / 127.f) : 1.f;
          float inv = 1.f / sc;
          u32x4 o;
#pragma unroll
          for (int i = 0; i < 4; ++i) {
            unsigned w = 0;
#pragma unroll
            for (int k = 0; k < 4; ++k) {
              float qf = rintf(v[rr][i][k] * inv);
              qf = fminf(fmaxf(qf, -127.f), 127.f);
              w |= ((unsigned)((int)qf + 128)) << (8 * k);
            }
            o[i] = w;
          }
          *(u32x4*)((tab == 0 ? p.u_q : p.v_q) + (size_t)r * 1024 + lane * 16) = o;
          if (lane == 0) (tab == 0 ? p.u_sc : p.v_sc)[r] = sc;
        }
      }
    }
  }
}

DI void phase_modulate(const Params& p, const float* xlat, const float* xctx, int nrows, int layer, int which) {
  const int lane = get_tid() & 63, wave = get_tid() >> 6;
  const float* nw = p.norm_w + (layer * 2 + which) * 1024;
  for (int row = blockIdx.x * 4 + wave; row < nrows; row += gridDim.x * 4) {
    const float* xr = row < NLAT ? xlat + (size_t)row * 1024 : xctx + (size_t)(row - NLAT) * 1024;
    int vec = vec_of_row(row);
    const float* sh = modp(p, layer, vec, which * 3 + 0);
    const float* sc = modp(p, layer, vec, which * 3 + 1);
    f32x4 v[4];
    float ss = 0.f;
#pragma unroll
    for (int i = 0; i < 4; ++i) {
      v[i] = *(const f32x4*)(xr + i * 256 + lane * 4);
      ss += v[i][0] * v[i][0] + v[i][1] * v[i][1] + v[i][2] * v[i][2] + v[i][3] * v[i][3];
    }
    ss = wave_sum(ss);
    float rstd = rsqrtf(ss * (1.f / 1024.f) + 1e-6f);
#pragma unroll
    for (int i = 0; i < 4; ++i) {
      int c0 = i * 256 + lane * 4;
      float4 w = *(const float4*)(nw + c0), s1 = *(const float4*)(sc + c0), s0 = *(const float4*)(sh + c0);
      float a = v[i][0] * rstd * w.x * (1.f + s1.x) + s0.x;
      float b = v[i][1] * rstd * w.y * (1.f + s1.y) + s0.y;
      float c = v[i][2] * rstd * w.z * (1.f + s1.z) + s0.z;
      float d = v[i][3] * rstd * w.w * (1.f + s1.w) + s0.w;
      uint2 o;
      o.x = pack2(a, b);
      o.y = pack2(c, d);
      *(uint2*)(p.mix + (size_t)row * 1024 + c0) = o;
    }
  }
}

enum { EPI_IN0 = 0, EPI_IN1 = 1, EPI_OUT = 2, EPI_PQ = 3 };
template <int EPI>
DI void phase_gemm(const Params& p, const bf16_t* A, const bf16_t* Bt, int M, int N, char* smem, int layer,
                           const float* xin_lat, const float* xin_ctx, int dry = 0) {
  constexpr int MI = 8;
  bf16_t* sbase = (bf16_t*)smem;
  const int tid = get_tid(), lane = tid & 63, wave = tid >> 6, q = lane >> 4, l15 = lane & 15;
  const int wm = wave >> 1, wn = wave & 1;
  const int ntn = N / 128, ntm = M / 256;
  const int lr = tid >> 2, lc = (tid & 3) * 8;
  const int xcd = blockIdx.x & 7, lcl = blockIdx.x >> 3, nl = gridDim.x >> 3;
  const int ngn = (ntn + 7) >> 3, ngm = (ntm + 7) >> 3;
  for (int wi = lcl; wi < ((ngn * ngm + 7) >> 3) * 64; wi += nl) {
    const int sid = (wi >> 6) * 8 + xcd, within = wi & 63;
    if (sid >= ngn * ngm) continue;
    const int tm = (sid / ngn) * 8 + (within >> 3), tn = (sid % ngn) * 8 + (within & 7);
    if (tm >= ntm || tn >= ntn) continue;
    f32x4 acc[MI][4];
#pragma unroll
    for (int i = 0; i < MI; ++i)
#pragma unroll
      for (int j = 0; j < 4; ++j) acc[i][j] = f32x4{0.f, 0.f, 0.f, 0.f};
    const bf16_t* Ag = A + (size_t)(tm * 256 + lr) * 1024 + lc;
    const bf16_t* Bg = Bt + (size_t)(tn * 128 + lr) * 1024 + lc;
    u32x4 ra[4], rb[2];
#pragma unroll
    for (int i = 0; i < 4; ++i) ra[i] = *(const u32x4*)(Ag + (size_t)i * 64 * 1024);
#pragma unroll
    for (int i = 0; i < 2; ++i) rb[i] = *(const u32x4*)(Bg + (size_t)i * 64 * 1024);
    __syncthreads();
    for (int kt = 0; kt < 32; ++kt) {
      bf16_t* cA = sbase + (kt & 1) * (384 * 48);
      bf16_t* cB = cA + 256 * 48;
#pragma unroll
      for (int i = 0; i < 4; ++i) *(u32x4*)(cA + (lr + 64 * i) * 48 + lc) = ra[i];
#pragma unroll
      for (int i = 0; i < 2; ++i) *(u32x4*)(cB + (lr + 64 * i) * 48 + lc) = rb[i];
      __syncthreads();
      if (kt + 1 < 32) {
#pragma unroll
        for (int i = 0; i < 4; ++i) ra[i] = *(const u32x4*)(Ag + (size_t)i * 64 * 1024 + (kt + 1) * 32);
#pragma unroll
        for (int i = 0; i < 2; ++i) rb[i] = *(const u32x4*)(Bg + (size_t)i * 64 * 1024 + (kt + 1) * 32);
      }
      bf16x8 bfr[4];
#pragma unroll
      for (int j = 0; j < 4; ++j) bfr[j] = ldfrag(cB + (wn * 64 + j * 16 + l15) * 48 + q * 8);
#pragma unroll
      for (int i = 0; i < MI; ++i) {
        bf16x8 af = ldfrag(cA + (wm * 128 + i * 16 + l15) * 48 + q * 8);
#pragma unroll
        for (int j = 0; j < 4; ++j) acc[i][j] = mfma16(bfr[j], af, acc[i][j]);
      }
    }
    const int colbase = tn * 128 + wn * 64;
    const int rowbase = tm * 256 + wm * 128;
    if (EPI == EPI_IN0 || EPI == EPI_IN1) {
      const int ld = EPI == EPI_IN0 ? LD0 : LD1;
      bool ropegrp = EPI == EPI_IN0 ? (colbase < 1024) : (colbase >= 2048 && colbase < 2688);
      bool lat = rowbase < NLAT;
      if (ropegrp && lat) {
#pragma unroll
        for (int i = 0; i < MI; ++i) {
          int row = rowbase + i * 16 + l15;
          int t = row & 2047, gr = t >> 6, gc = t & 63;
          const f32x4* pr = (const f32x4*)(p.rope + (gr * 16 + q * 4) * 2);
          const f32x4* pc = (const f32x4*)(p.rope + (gc * 16 + q * 4) * 2);
          f32x4 r0 = pr[0], r1 = pr[1], c0 = pc[0], c1 = pc[1];
          float crc[4] = {r0[0], r0[2], r1[0], r1[2]}, crs[4] = {r0[1], r0[3], r1[1], r1[3]};
          float ccc[4] = {c0[0], c0[2], c1[0], c1[2]}, ccs[4] = {c0[1], c0[3], c1[1], c1[3]};
          float o1[4], o2[4], o3[4], o4[4];
#pragma unroll
          for (int r = 0; r < 4; ++r) {
            float x1 = acc[i][0][r], x2 = acc[i][1][r], x3 = acc[i][2][r], x4 = acc[i][3][r];
            o1[r] = x1 * crc[r] - x2 * crs[r];
            o2[r] = x2 * crc[r] + x1 * crs[r];
            o3[r] = x3 * ccc[r] - x4 * ccs[r];
            o4[r] = x4 * ccc[r] + x3 * ccs[r];
          }
          bf16_t* o = p.proj + (size_t)row * ld + colbase + q * 4;
          *(uint2*)(o) = uint2{pack2(o1[0], o1[1]), pack2(o1[2], o1[3])};
          *(uint2*)(o + 16) = uint2{pack2(o2[0], o2[1]), pack2(o2[2], o2[3])};
          *(uint2*)(o + 32) = uint2{pack2(o3[0], o3[1]), pack2(o3[2], o3[3])};
          *(uint2*)(o + 48) = uint2{pack2(o4[0], o4[1]), pack2(o4[2], o4[3])};
        }
      } else {
#pragma unroll
        for (int i = 0; i < MI; ++i) {
          int row = rowbase + i * 16 + l15;
#pragma unroll
          for (int j = 0; j < 4; ++j) {
            int col = colbase + j * 16 + q * 4;
            if (EPI == EPI_IN0 || col < 2832)
              *(uint2*)(p.proj + (size_t)row * ld + col) = uint2{pack2(acc[i][j][0], acc[i][j][1]), pack2(acc[i][j][2], acc[i][j][3])};
          }
        }
      }
    } else if (EPI == EPI_OUT) {
#pragma unroll
      for (int i = 0; i < MI; ++i) {
        int row = rowbase + i * 16 + l15;
        const float* g1 = modp(p, layer, vec_of_row(row), 2);
        const float* xi = row < NLAT ? xin_lat + (size_t)row * 1024 : xin_ctx + (size_t)(row - NLAT) * 1024;
        float* xo = row < NLAT ? p.out + (size_t)row * 1024 : p.xc + (size_t)(row - NLAT) * 1024;
#pragma unroll
        for (int j = 0; j < 4; ++j) {
          int col = colbase + j * 16 + q * 4;
          f32x4 xv = *(const f32x4*)(xi + col), gv = *(const f32x4*)(g1 + col);
          f32x4 nv;
#pragma unroll
          for (int r = 0; r < 4; ++r) nv[r] = xv[r] + gv[r] * acc[i][j][r];
          if (!dry || nv[0] == -12345.678f) *(f32x4*)(xo + col) = nv;
        }
      }
    } else {
#pragma unroll
      for (int i = 0; i < MI; ++i) {
        int row = rowbase + i * 16 + l15;
#pragma unroll
        for (int j = 0; j < 4; ++j) {
          int col = colbase + j * 16 + q * 4;
          *(f32x4*)(p.pq + (size_t)row * 2048 + col) = acc[i][j];
        }
      }
    }
  }
}

template <int DV, int NC>
DI void flash_item(char* smem, const bf16_t* Qb, int ld, const bf16_t* Kc, const bf16_t* Vc, const bf16_t* Kl,
                   const bf16_t* Vl, int l_lo, int l_hi, int qpos0, int window, float sink, float scale,
                   f32x4 (&o)[NC][DV / 16], float (&m)[NC], float (&l)[NC]) {
  bf16_t* sK = (bf16_t*)smem;
  bf16_t* sVt = sK + NC * 64 * 80;
  const int tid0 = get_tid();
  const float L2E = 1.4426950408889634f;
  const float sc2 = scale * L2E;
  bf16x8 qf[NC][2];
  {
  const int lane = tid0 & 63, wave = tid0 >> 6, q = lane >> 4, l15 = lane & 15;
#pragma unroll
  for (int c = 0; c < NC; ++c)
#pragma unroll
    for (int ks = 0; ks < 2; ++ks)
      qf[c][ks] = *(const bf16x8*)(Qb + (size_t)(wave * 16 + l15) * ld + c * 64 + ks * 32 + q * 8);
  }
#pragma unroll
  for (int c = 0; c < NC; ++c) {
    m[c] = sink == -INFINITY ? -INFINITY : sink * L2E;
    l[c] = sink == -INFINITY ? 0.f : 1.f;
#pragma unroll
    for (int n = 0; n < DV / 16; ++n) o[c][n] = f32x4{0.f, 0.f, 0.f, 0.f};
  }
  const int nlt = l_hi > l_lo ? (l_hi - l_lo) / 64 : 0;
  const int ntiles = 4 + nlt;
  u32x4 kreg[NC][2], vreg[DV / 32];
  auto load_tile = [&](int it2) {
    const int tidl = tid0;
    const bf16_t *Kr2, *Vr2;
    if (it2 < 4) {
      Kr2 = Kc + (size_t)(it2 * 64) * ld;
      Vr2 = Vc + (size_t)(it2 * 64) * ld;
    } else {
      int kp = l_lo + (it2 - 4) * 64;
      Kr2 = Kl + (size_t)kp * ld;
      Vr2 = Vl + (size_t)kp * ld;
    }
    int key = tidl >> 2, part = tidl & 3;
#pragma unroll
    for (int c = 0; c < NC; ++c) {
      const bf16_t* sp = Kr2 + (size_t)key * ld + c * 64 + part * 16;
      kreg[c][0] = *(const u32x4*)sp;
      kreg[c][1] = *(const u32x4*)(sp + 8);
    }
    int vkey = tidl & 63, cg4 = tidl >> 6;
#pragma unroll
    for (int i = 0; i < DV / 32; ++i) vreg[i] = *(const u32x4*)(Vr2 + (size_t)vkey * ld + (cg4 + 4 * i) * 8);
  };
  load_tile(0);
  for (int it = 0; it < ntiles; ++it) {
    int tid = tid0;
    asm volatile("" : "+v"(tid));
    const int lane = tid & 63, wave = tid >> 6, q = lane >> 4, l15 = lane & 15;
    const int kpos0 = it < 4 ? -(1 << 28) : l_lo + (it - 4) * 64;
    __syncthreads();
    {
      int key = tid >> 2, part = tid & 3;
#pragma unroll
      for (int c = 0; c < NC; ++c) {
        *(u32x4*)(sK + (c * 64 + key) * 80 + part * 16) = kreg[c][0];
        *(u32x4*)(sK + (c * 64 + key) * 80 + part * 16 + 8) = kreg[c][1];
      }
      int vkey = tid & 63, cg4 = tid >> 6;
#pragma unroll
      for (int i = 0; i < DV / 32; ++i) {
        int e0 = (cg4 + 4 * i) * 8;
#pragma unroll
        for (int j = 0; j < 4; ++j) {
          sVt[(e0 + 2 * j) * 72 + vkey] = (bf16_t)(vreg[i][j] & 0xffffu);
          sVt[(e0 + 2 * j + 1) * 72 + vkey] = (bf16_t)(vreg[i][j] >> 16);
        }
      }
    }
    __syncthreads();
    if (it + 1 < ntiles) load_tile(it + 1);
    bf16x8 pf[NC][2];
#pragma unroll
    for (int c = 0; c < NC; ++c) {
      f32x4 s[4];
#pragma unroll
      for (int nt = 0; nt < 4; ++nt) {
        s[nt] = f32x4{0.f, 0.f, 0.f, 0.f};
#pragma unroll
        for (int ks = 0; ks < 2; ++ks)
          s[nt] = mfma16(ldfrag(sK + (c * 64 + nt * 16 + l15) * 80 + ks * 32 + q * 8), qf[c][ks], s[nt]);
      }
      float mx = -INFINITY;
      if (NC == 1 && kpos0 >= 0) {
#pragma unroll
        for (int nt = 0; nt < 4; ++nt)
#pragma unroll
          for (int r = 0; r < 4; ++r) {
            int d = (kpos0 + nt * 16 + q * 4 + r) - (qpos0 + wave * 16 + l15);
            if (d > window || d < -window) s[nt][r] = -INFINITY;
          }
      }
#pragma unroll
      for (int nt = 0; nt < 4; ++nt)
#pragma unroll
        for (int r = 0; r < 4; ++r) mx = fmaxf(mx, s[nt][r]);
      mx = rows_max(mx) * sc2;
      const float mn = fmaxf(m[c], mx);
      const float alpha = __builtin_amdgcn_exp2f(m[c] - mn);
      float rs = 0.f;
#pragma unroll
      for (int nt = 0; nt < 4; ++nt)
#pragma unroll
        for (int r = 0; r < 4; ++r) {
          float pv = __builtin_amdgcn_exp2f(__builtin_fmaf(s[nt][r], sc2, -mn));
          s[nt][r] = pv;
          rs += pv;
        }
      rs = rows_sum(rs);
      l[c] = l[c] * alpha + rs;
      m[c] = mn;
#pragma unroll
      for (int n = 0; n < DV / 16; ++n)
#pragma unroll
        for (int r = 0; r < 4; ++r) o[c][n][r] *= alpha;
      pf[c][0] = packfrag(s[0], s[1]);
      pf[c][1] = packfrag(s[2], s[3]);
    }
#pragma unroll
    for (int ks = 0; ks < 2; ++ks) {
#pragma unroll
      for (int n = 0; n < DV / 16; ++n) {
        bf16x8 vf = ldfrag_perm(sVt + (n * 16 + l15) * 72, ks, q);
#pragma unroll
        for (int c = 0; c < NC; ++c) o[c][n] = mfma16(vf, pf[c][ks], o[c][n]);
      }
    }
  }
}

DI void diff_item(const Params& p, char* smem, int b, int h, int qb, bool is_ctx, float lam) {
  const int lane = get_tid() & 63, wave = get_tid() >> 6, q = lane >> 4, l15 = lane & 15;
  const int ctxrow0 = NLAT + b * LL;
  const int qrow0 = is_ctx ? ctxrow0 + qb * 64 : b * TT + qb * 64;
  const bf16_t* Qb = p.proj + (size_t)qrow0 * LD0 + h * 128;
  const bf16_t* Kc = p.proj + (size_t)ctxrow0 * LD0 + 512 + h * 128;
  const bf16_t* Vc = p.proj + (size_t)ctxrow0 * LD0 + 1024 + h * 128;
  const bf16_t* Kl = p.proj + (size_t)(b * TT) * LD0 + 512 + h * 128;
  const bf16_t* Vl = p.proj + (size_t)(b * TT) * LD0 + 1024 + h * 128;
  f32x4 o[2][8];
  float m[2], l[2];
  flash_item<128, 2>(smem, Qb, LD0, Kc, Vc, Kl, Vl, 0, is_ctx ? 0 : TT, 0, -1, -INFINITY, 0.125f, o, m, l);
  const float* sw = p.diff_subln_w;
  const float i0 = 1.f / l[0], i1 = lam / l[1];
  float ss = 0.f;
#pragma unroll
  for (int n = 0; n < 8; ++n)
#pragma unroll
    for (int r = 0; r < 4; ++r) {
      float v = o[0][n][r] * i0 - o[1][n][r] * i1;
      o[0][n][r] = v;
      ss += v * v;
    }
  ss = rows_sum(ss);
  const float rstd = rsqrtf(ss * (1.f / 128.f) + 1e-6f) * 0.8f;
  const int row = qrow0 + wave * 16 + l15;
#pragma unroll
  for (int n = 0; n < 8; ++n) {
    f32x4 w4 = *(const f32x4*)(sw + n * 16 + q * 4);
    uint2 ov;
    ov.x = pack2(o[0][n][0] * rstd * w4[0], o[0][n][1] * rstd * w4[1]);
    ov.y = pack2(o[0][n][2] * rstd * w4[2], o[0][n][3] * rstd * w4[3]);
    *(uint2*)(p.mix + (size_t)row * 1024 + h * 128 + n * 16 + q * 4) = ov;
  }
}

DI void swa_item(const Params& p, char* smem, int b, int h, int qb) {
  const int lane = get_tid() & 63, wave = get_tid() >> 6, q = lane >> 4, l15 = lane & 15;
  const int kvh = h >> 2;
  const int ctxrow0 = NLAT + b * LL;
  const int qrow0 = b * TT + qb * 64;
  const bf16_t* Qb = p.proj + (size_t)qrow0 * LD1 + 2048 + h * 64;
  const bf16_t* Kc = p.proj + (size_t)ctxrow0 * LD1 + 2560 + kvh * 64;
  const bf16_t* Vc = p.proj + (size_t)ctxrow0 * LD1 + 2688 + kvh * 64;
  const bf16_t* Kl = p.proj + (size_t)(b * TT) * LD1 + 2560 + kvh * 64;
  const bf16_t* Vl = p.proj + (size_t)(b * TT) * LD1 + 2688 + kvh * 64;
  int lo = qb * 64 - 128, hi = qb * 64 + 64 + 128;
  if (lo < 0) lo = 0;
  if (hi > TT) hi = TT;
  f32x4 o[1][4];
  float m[1], l[1];
  flash_item<64, 1>(smem, Qb, LD1, Kc, Vc, Kl, Vl, lo, hi, qb * 64, 128, p.swa_sink[h], 0.125f, o, m, l);
  const float inv = 1.f / l[0];
  const int row = qrow0 + wave * 16 + l15;
#pragma unroll
  for (int n = 0; n < 4; ++n) {
    uint2 ov;
    ov.x = pack2(o[0][n][0] * inv, o[0][n][1] * inv);
    ov.y = pack2(o[0][n][2] * inv, o[0][n][3] * inv);
    *(uint2*)(p.mix + (size_t)row * 1024 + 512 + h * 64 + n * 16 + q * 4) = ov;
  }
}

DI void hgrn_item(const Params& p, char* smem, int b, int head) {
  bf16_t* sQt = (bf16_t*)smem;
  bf16_t* sKt = sQt + 32 * 72;
  bf16_t* sQS = sKt + 32 * 72;
  bf16_t* sKST = sQS + 32 * 72;
  bf16_t* sVT = sKST + 64 * 40;
  bf16_t* sAtt = sVT + 64 * 40;
  bf16_t* sST = sAtt + 32 * 40;
  float* sO = (float*)(sST + 64 * 72);
  float* sGs = sO + 32 * 65;
  float* sG16 = sGs + 256;
  float* sEB = sG16 + 64;
  const int tid0 = get_tid();
  const int ch = head * 64 + (tid0 & 63);
  float lb;
  {
    float a0 = p.hgrn_lb[ch], a1 = p.hgrn_lb[512 + ch], a2 = p.hgrn_lb[1024 + ch];
    float mx = fmaxf(a0, fmaxf(a1, a2));
    float e0 = expf(a0 - mx), e1 = expf(a1 - mx), e2 = expf(a2 - mx);
    lb = e0 / (e0 + e1 + e2);
  }
  for (int dir = 0; dir < 2; ++dir) {
    const bool rev = dir == 1;
    f32x4 S[4];
    bf16_t nq[8], ni[8], nf[8];
#pragma unroll
    for (int n = 0; n < 4; ++n) S[n] = f32x4{0.f, 0.f, 0.f, 0.f};
    __syncthreads();
    for (int i = tid0; i < 64 * 72; i += NTHREADS) sST[i] = 0;
    for (int step = 0; step < 72; ++step) {
      int tid = tid0;
      asm volatile("" : "+v"(tid));
      const int lane = tid & 63, wave = tid >> 6, q = lane >> 4, l15 = lane & 15;
      const int c = tid & 63, tg = tid >> 6;
      const bool isctx = step < 8;
      const int n = isctx ? LL : TT;
      const int j = isctx ? step : step - 8;
      const int rowseg = isctx ? NLAT + b * LL : b * TT;
      float qv[8], kk[8], vv[8], cs[8];
      float run = 0.f;
      if (step == 0) {
#pragma unroll
        for (int jj = 0; jj < 8; ++jj) {
          int pp = tg * 8 + jj;
          int tok = rev ? n - 1 - (32 * j + pp) : 32 * j + pp;
          const bf16_t* pr = p.proj + (size_t)(rowseg + tok) * LD0;
          nq[jj] = pr[1536 + ch];
          ni[jj] = pr[2048 + ch];
          nf[jj] = pr[(rev ? 3072 : 2560) + ch];
        }
      }
#pragma unroll
      for (int jj = 0; jj < 8; ++jj) {
        float qr = bf2f(nq[jj]), ir = bf2f(ni[jj]), fl = bf2f(nf[jj]);
        qv[jj] = silu_fast(qr) * 0.125f;
        float f = lb + (1.f - lb) * __fdividef(1.f, 1.f + __expf(-fl));
        kk[jj] = 1.f - f;
        vv[jj] = ir;
        run += __logf(f);
        cs[jj] = run;
      }
      if (step + 1 < 72) {
        const int s2 = step + 1;
        const bool isctx2 = s2 < 8;
        const int n2 = isctx2 ? LL : TT;
        const int j2 = isctx2 ? s2 : s2 - 8;
        const int rowseg2 = isctx2 ? NLAT + b * LL : b * TT;
#pragma unroll
        for (int jj = 0; jj < 8; ++jj) {
          int pp = tg * 8 + jj;
          int tok = rev ? n2 - 1 - (32 * j2 + pp) : 32 * j2 + pp;
          const bf16_t* pr = p.proj + (size_t)(rowseg2 + tok) * LD0;
          nq[jj] = pr[1536 + ch];
          ni[jj] = pr[2048 + ch];
          nf[jj] = pr[(rev ? 3072 : 2560) + ch];
        }
      }
      sGs[tg * 64 + c] = run;
      if (tg == 2) sG16[c] = cs[0];
      __syncthreads();
      {
        float g0 = sGs[c], g1 = sGs[64 + c], g2 = sGs[128 + c], g3 = sGs[192 + c];
        float off = tg == 0 ? 0.f : (tg == 1 ? g0 : (tg == 2 ? g0 + g1 : g0 + g1 + g2));
        float blast = g0 + g1 + g2 + g3;
        float ref = g0 + g1 + sG16[c];
#pragma unroll
        for (int jj = 0; jj < 8; ++jj) {
          int pp = tg * 8 + jj;
          float bj = off + cs[jj];
          sQt[pp * 72 + c] = f2bf(qv[jj] * __expf(bj - ref));
          sKt[pp * 72 + c] = f2bf(kk[jj] * __expf(ref - bj));
          sQS[pp * 72 + c] = f2bf(qv[jj] * __expf(bj));
          sKST[c * 40 + pp] = f2bf(kk[jj] * __expf(blast - bj));
          sVT[c * 40 + pp] = f2bf(vv[jj]);
        }
        if (tg == 0) sEB[c] = __expf(blast);
      }
      __syncthreads();
      {
        const int mt = wave & 1, nt0 = (wave >> 1) * 2;
        f32x4 aT[2];
#pragma unroll
        for (int kt = 0; kt < 2; ++kt) {
          aT[kt] = f32x4{0.f, 0.f, 0.f, 0.f};
#pragma unroll
          for (int ks = 0; ks < 2; ++ks)
            aT[kt] = mfma16(ldfrag(sKt + (kt * 16 + l15) * 72 + ks * 32 + q * 8),
                            ldfrag(sQt + (mt * 16 + l15) * 72 + ks * 32 + q * 8), aT[kt]);
#pragma unroll
          for (int r = 0; r < 4; ++r) {
            int ki = kt * 16 + q * 4 + r, qi = mt * 16 + l15;
            if (ki > qi) aT[kt][r] = 0.f;
          }
        }
        const bf16x8 attf = packfrag(aT[0], aT[1]);
        const bf16x8 q0 = ldfrag(sQS + (mt * 16 + l15) * 72 + q * 8), q1 = ldfrag(sQS + (mt * 16 + l15) * 72 + 32 + q * 8);
#pragma unroll
        for (int t2 = 0; t2 < 2; ++t2) {
          int nt = nt0 + t2;
          f32x4 a = f32x4{0.f, 0.f, 0.f, 0.f};
          a = mfma16(ldfrag_perm(sVT + (nt * 16 + l15) * 40, 0, q), attf, a);
          a = mfma16(ldfrag(sST + (nt * 16 + l15) * 72 + q * 8), q0, a);
          a = mfma16(ldfrag(sST + (nt * 16 + l15) * 72 + 32 + q * 8), q1, a);
#pragma unroll
          for (int r = 0; r < 4; ++r) sO[(mt * 16 + l15) * 65 + nt * 16 + q * 4 + r] = a[r];
        }
      }
      __syncthreads();
      {
        bf16x8 af = ldfrag(sKST + (wave * 16 + l15) * 40 + q * 8);
        float eb[4];
#pragma unroll
        for (int r = 0; r < 4; ++r) eb[r] = sEB[wave * 16 + q * 4 + r];
#pragma unroll
        for (int nt = 0; nt < 4; ++nt) {
#pragma unroll
          for (int r = 0; r < 4; ++r) S[nt][r] *= eb[r];
          S[nt] = mfma16(af, ldfrag(sVT + (nt * 16 + l15) * 40 + q * 8), S[nt]);
          uint2 w;
          w.x = pack2(S[nt][0], S[nt][1]);
          w.y = pack2(S[nt][2], S[nt][3]);
          *(uint2*)(sST + (nt * 16 + l15) * 72 + wave * 16 + q * 4) = w;
        }
        int pp = tid >> 3, eg = tid & 7;
        int tok = rev ? n - 1 - (32 * j + pp) : 32 * j + pp;
        size_t row = (size_t)(rowseg + tok);
        bf16_t* dst = p.mix + row * 1024 + 512 + head * 64 + eg * 8;
        float val[8];
#pragma unroll
        for (int k = 0; k < 8; ++k) val[k] = sO[pp * 65 + eg * 8 + k];
        if (!rev) {
          uint4 w;
          w.x = pack2(val[0], val[1]);
          w.y = pack2(val[2], val[3]);
          w.z = pack2(val[4], val[5]);
          w.w = pack2(val[6], val[7]);
          *(uint4*)dst = w;
        } else {
          uint4 of = *(const uint4*)dst;
          unsigned ow[4] = {of.x, of.y, of.z, of.w};
          float ss = 0.f;
#pragma unroll
          for (int k = 0; k < 4; ++k) {
            val[2 * k] += __uint_as_float(ow[k] << 16);
            val[2 * k + 1] += __uint_as_float(ow[k] & 0xffff0000u);
          }
#pragma unroll
          for (int k = 0; k < 8; ++k) ss += val[k] * val[k];
          ss += __shfl_xor(ss, 1);
          ss += __shfl_xor(ss, 2);
          ss += __shfl_xor(ss, 4);
          float rstd = rsqrtf(ss * (1.f / 64.f) + 1e-6f);
          uint4 gq = *(const uint4*)(p.proj + row * LD0 + 3584 + head * 64 + eg * 8);
          unsigned gw[4] = {gq.x, gq.y, gq.z, gq.w};
          float outv[8];
#pragma unroll
          for (int k = 0; k < 4; ++k) {
            float ga = __uint_as_float(gw[k] << 16), gb = __uint_as_float(gw[k] & 0xffff0000u);
            outv[2 * k] = val[2 * k] * rstd * p.hgrn_norm_w[eg * 8 + 2 * k] * silu_fast(ga);
            outv[2 * k + 1] = val[2 * k + 1] * rstd * p.hgrn_norm_w[eg * 8 + 2 * k + 1] * silu_fast(gb);
          }
          uint4 w;
          w.x = pack2(outv[0], outv[1]);
          w.y = pack2(outv[2], outv[3]);
          w.z = pack2(outv[4], outv[5]);
          w.w = pack2(outv[6], outv[7]);
          *(uint4*)dst = w;
        }
      }
    }
  }
}

DI void gdn_item(const Params& p, char* smem, int b, int head, int dir, int ehalf) {
  bf16_t* sQ = (bf16_t*)smem;
  bf16_t* sK = sQ + 64 * 136;
  bf16_t* sW = sK + 64 * 136;
  bf16_t* sV = sW + 64 * 136;
  float* sA = (float*)(sV + 64 * 72);
  float* sG = sA + 64 * 64;
  float* sBeta = sG + 64;
  float* sRq = sBeta + 64;
  float* sRk = sRq + 64;
  float* sEg = sRk + 64;
  bf16_t* sKdT = sW;
  bf16_t* sAtt = (bf16_t*)sA;
  const int tid0 = get_tid();
  const bool rev = dir == 1;
  const float neg_a = -expf(p.gdn_a_log[dir * 4 + head]);
  const float dtb = p.gdn_dt_bias[dir * 4 + head];
  bf16_t* gout = (dir == 0 ? p.gdn_of : p.gdn_ob);
  f32x4 S[8];
#pragma unroll
  for (int i = 0; i < 8; ++i) S[i] = f32x4{0.f, 0.f, 0.f, 0.f};
  for (int step = 0; step < 36; ++step) {
    int tid = tid0;
    asm volatile("" : "+v"(tid));
    const int lane = tid & 63, wave = tid >> 6, q = lane >> 4, l15 = lane & 15;
    const bool isctx = step < 4;
    const int n = isctx ? LL : TT;
    const int j = isctx ? step : step - 4;
    const int rowseg = isctx ? NLAT + b * LL : b * TT;
    const int lo = rev ? n - 64 * (j + 1) : 64 * j;
    __syncthreads();
    {
      bf16_t* rawA = sW;
      bf16_t* rawV = (bf16_t*)sA;
      const bf16_t* gbase = p.proj + (size_t)rowseg * LD1;
      const u32x4 zz = u32x4{0u, 0u, 0u, 0u};
      u32x4 rq[5], rk[5], rv[3];
#pragma unroll
      for (int i = 0; i < 5; ++i) {
        int chn = tid + 256 * i;
        int row = chn >> 4, part = chn & 15;
        int t = lo - 2 + row;
        bool ok = chn < 1088 && t >= 0 && t < n;
        const bf16_t* gp = gbase + (size_t)(ok ? t : 0) * LD1 + head * 128 + part * 8;
        rq[i] = ok ? *(const u32x4*)gp : zz;
        rk[i] = ok ? *(const u32x4*)(gp + 512) : zz;
      }
#pragma unroll
      for (int i = 0; i < 3; ++i) {
        int chn = tid + 256 * i;
        int row = chn >> 3, part = chn & 7;
        int t = lo - 2 + row;
        bool ok = chn < 544 && t >= 0 && t < n;
        const bf16_t* gp = gbase + (size_t)(ok ? t : 0) * LD1 + 1024 + head * 128 + ehalf * 64 + part * 8;
        rv[i] = ok ? *(const u32x4*)gp : zz;
      }
#pragma unroll
      for (int i = 0; i < 5; ++i) {
        int chn = tid + 256 * i;
        if (chn < 1088) *(u32x4*)(rawA + chn * 8) = rq[i];
      }
#pragma unroll
      for (int i = 0; i < 3; ++i) {
        int chn = tid + 256 * i;
        if (chn < 544) *(u32x4*)(rawV + chn * 8) = rv[i];
      }
      __syncthreads();
      const int c = tid & 127, th = tid >> 7;
      auto conv_from = [&](const bf16_t* raw, int stride, int col, bf16_t* dst, int dstride) {
        float w0 = p.gdn_conv_w[col], w1 = p.gdn_conv_w[1536 + col], w2 = p.gdn_conv_w[2 * 1536 + col],
              w3 = p.gdn_conv_w[3 * 1536 + col], w4 = p.gdn_conv_w[4 * 1536 + col];
        const bf16_t* rp = raw + (th * 32) * stride + c;
        float x0 = bf2f(rp[0]), x1 = bf2f(rp[stride]), x2 = bf2f(rp[2 * stride]), x3 = bf2f(rp[3 * stride]);
#pragma unroll
        for (int tt = 0; tt < 32; ++tt) {
          float x4 = bf2f(rp[(tt + 4) * stride]);
          float y = w0 * x0 + w1 * x1 + w2 * x2 + w3 * x3 + w4 * x4;
          y = silu_fast(y);
          int tl = th * 32 + tt;
          int pp = rev ? 63 - tl : tl;
          dst[pp * dstride + c] = f2bf(y);
          x0 = x1; x1 = x2; x2 = x3; x3 = x4;
        }
      };
      conv_from(rawA, 128, head * 128 + c, sQ, 136);
      if (c < 64) conv_from(rawV, 64, 1024 + head * 128 + ehalf * 64 + c, sV, 72);
      __syncthreads();
#pragma unroll
      for (int i = 0; i < 5; ++i) {
        int chn = tid + 256 * i;
        if (chn < 1088) *(u32x4*)(rawA + chn * 8) = rk[i];
      }
      __syncthreads();
      conv_from(rawA, 128, 512 + head * 128 + c, sK, 136);
      if (tid < 64) {
        int pp = tid;
        int tok = rev ? n - 1 - (64 * j + pp) : 64 * j + pp;
        const bf16_t* pr = p.proj + (size_t)(rowseg + tok) * LD1 + 2816;
        float a = bf2f(pr[dir * 4 + head]), bt = bf2f(pr[8 + dir * 4 + head]);
        float xs = a + dtb;
        float sp = xs > 20.f ? xs : log1pf(expf(xs));
        float g = neg_a * sp;
#pragma unroll
        for (int o = 1; o < 64; o <<= 1) {
          float t = __shfl_up(g, o);
          if (lane >= o) g += t;
        }
        sG[pp] = g;
        sEg[pp] = expf(g);
        sBeta[pp] = sigmoidf_(bt);
      }
    }
    __syncthreads();
    {
      int pp = tid >> 2, part = tid & 3;
      float sq = 0.f, sk = 0.f;
#pragma unroll 8
      for (int k = 0; k < 32; ++k) {
        float a = bf2f(sQ[pp * 136 + part * 32 + k]), bb = bf2f(sK[pp * 136 + part * 32 + k]);
        sq += a * a;
        sk += bb * bb;
      }
      sq += __shfl_xor(sq, 1); sq += __shfl_xor(sq, 2);
      sk += __shfl_xor(sk, 1); sk += __shfl_xor(sk, 2);
      if (part == 0) {
        sRq[pp] = rsqrtf(sq + 1e-6f) * 0.08838834764831845f;
        sRk[pp] = rsqrtf(sk + 1e-6f);
      }
    }
    __syncthreads();
    {
      const int mt = wave;
#pragma unroll
      for (int nt = 0; nt < 4; ++nt) {
        f32x4 a = f32x4{0.f, 0.f, 0.f, 0.f};
        if (nt <= mt) {
#pragma unroll
          for (int ks = 0; ks < 4; ++ks)
            a = mfma16(ldfrag(sK + (mt * 16 + l15) * 136 + ks * 32 + q * 8),
                       ldfrag(sK + (nt * 16 + l15) * 136 + ks * 32 + q * 8), a);
        }
        int jj = nt * 16 + l15;
        float rkj = sRk[jj], gj = sG[jj];
        f32x4 av;
#pragma unroll
        for (int r = 0; r < 4; ++r) {
          int ii = mt * 16 + q * 4 + r;
          float v = 0.f;
          if (ii > jj) v = a[r] * sRk[ii] * rkj * sBeta[ii] * __expf(sG[ii] - gj);
          av[r] = v;
        }
        *(f32x4*)(sA + jj * 64 + mt * 16 + q * 4) = av;
      }
    }
    __syncthreads();
    {
      auto solve = [&](auto UP, int cidx) {
        constexpr bool upart = decltype(UP)::value;
        bf16_t* dstb = upart ? sV + cidx : sW + cidx;
        const bf16_t* srcb = upart ? sV + cidx : sK + cidx;
        constexpr int dstr = upart ? 72 : 136;
#pragma unroll 1
        for (int bi = 0; bi < 4; ++bi) {
          float acc[16];
#pragma unroll
          for (int r = 0; r < 16; ++r) {
            int i = bi * 16 + r;
            float rv = bf2f(srcb[i * dstr]) * sBeta[i];
            if (!upart) rv *= sRk[i] * sEg[i];
            acc[r] = rv;
          }
#pragma unroll 8
          for (int j = 0; j < bi * 16; ++j) {
            float sj = bf2f(dstb[j * dstr]);
            const f32x4* ap = (const f32x4*)(sA + j * 64 + bi * 16);
            f32x4 a0 = ap[0], a1 = ap[1], a2 = ap[2], a3 = ap[3];
#pragma unroll
            for (int k = 0; k < 4; ++k) {
              acc[k] -= a0[k] * sj;
              acc[4 + k] -= a1[k] * sj;
              acc[8 + k] -= a2[k] * sj;
              acc[12 + k] -= a3[k] * sj;
            }
          }
          const float* ab = sA + (bi * 16) * 64 + bi * 16;
#pragma unroll
          for (int r = 0; r < 16; ++r) {
            float sr = acc[r];
            dstb[(bi * 16 + r) * dstr] = f2bf(sr);
#pragma unroll
            for (int r2 = r + 1; r2 < 16; ++r2) acc[r2] -= ab[r * 64 + r2] * sr;
            if ((r & 7) == 7) __builtin_amdgcn_sched_barrier(0);
          }
        }
      };
      if (tid < 64) solve(std::true_type{}, tid);
      else if (tid < 192) solve(std::false_type{}, tid - 64);
    }
    __syncthreads();
    f32x4 vn[4], oo[4];
    {
      bf16x8 sf[4];
#pragma unroll
      for (int ks = 0; ks < 4; ++ks) sf[ks] = packfrag(S[2 * ks], S[2 * ks + 1]);
#pragma unroll
      for (int mt = 0; mt < 4; ++mt) {
        f32x4 ws = f32x4{0.f, 0.f, 0.f, 0.f}, qs = f32x4{0.f, 0.f, 0.f, 0.f};
#pragma unroll
        for (int ks = 0; ks < 4; ++ks) {
          ws = mfma16(ldfrag_perm(sW + (mt * 16 + l15) * 136, ks, q), sf[ks], ws);
          qs = mfma16(ldfrag_perm(sQ + (mt * 16 + l15) * 136, ks, q), sf[ks], qs);
        }
#pragma unroll
        for (int r = 0; r < 4; ++r) {
          int ii = mt * 16 + q * 4 + r;
          vn[mt][r] = bf2f(sV[ii * 72 + wave * 16 + l15]) - ws[r];
          oo[mt][r] = qs[r] * sRq[ii] * sEg[ii];
        }
        asm volatile("" : "+v"(vn[mt]), "+v"(oo[mt]));
      }
    }
    __syncthreads();
    {
      const int d = tid & 127, hf = tid >> 7;
      const float glast = sG[63];
#pragma unroll 4
      for (int jj = 0; jj < 32; ++jj) {
        int jt = hf * 32 + jj;
        sKdT[d * 68 + jt] = f2bf(bf2f(sK[jt * 136 + d]) * sRk[jt] * __expf(glast - sG[jt]));
      }
      const int mt = wave;
      f32x4 a[4];
#pragma unroll
      for (int nt = 0; nt < 4; ++nt) {
        a[nt] = f32x4{0.f, 0.f, 0.f, 0.f};
        if (nt <= mt) {
#pragma unroll
          for (int ks = 0; ks < 4; ++ks)
            a[nt] = mfma16(ldfrag(sQ + (mt * 16 + l15) * 136 + ks * 32 + q * 8),
                           ldfrag(sK + (nt * 16 + l15) * 136 + ks * 32 + q * 8), a[nt]);
        }
      }
#pragma unroll
      for (int nt = 0; nt < 4; ++nt) {
        int jj = nt * 16 + l15;
        float rkj = sRk[jj], gj = sG[jj];
#pragma unroll
        for (int r = 0; r < 4; ++r) {
          int ii = mt * 16 + q * 4 + r;
          float v = 0.f;
          if (ii >= jj) v = a[nt][r] * sRq[ii] * rkj * __expf(sG[ii] - gj);
          sAtt[ii * 72 + jj] = f2bf(v);
        }
      }
    }
    __syncthreads();
    {
      bf16x8 vf[2];
      vf[0] = packfrag(vn[0], vn[1]);
      vf[1] = packfrag(vn[2], vn[3]);
#pragma unroll
      for (int mt = 0; mt < 4; ++mt)
#pragma unroll
        for (int ks = 0; ks < 2; ++ks) oo[mt] = mfma16(ldfrag_perm(sAtt + (mt * 16 + l15) * 72, ks, q), vf[ks], oo[mt]);
      __builtin_amdgcn_sched_barrier(0);
      if (!isctx) {
        bf16_t* gb = gout + (size_t)(b * TT) * 512 + head * 128 + ehalf * 64;
        const int tok0 = rev ? n - 1 - (64 * j + q * 4) : 64 * j + q * 4;
        const int tstep = rev ? -512 : 512;
        unsigned off0 = (unsigned)(tok0 * 512 + wave * 16 + l15);
#pragma unroll
        for (int mt = 0; mt < 4; ++mt)
#pragma unroll
          for (int r = 0; r < 4; ++r) {
            unsigned off = off0 + (unsigned)((mt * 16 + r) * tstep);
            gb[off] = f2bf(oo[mt][r]);
          }
      }
      __builtin_amdgcn_sched_barrier(0);
      const float egl = sEg[63];
#pragma unroll
      for (int m8 = 0; m8 < 8; ++m8) {
#pragma unroll
        for (int r = 0; r < 4; ++r) S[m8][r] *= egl;
#pragma unroll
        for (int ks = 0; ks < 2; ++ks) S[m8] = mfma16(ldfrag_perm(sKdT + (m8 * 16 + l15) * 68, ks, q), vf[ks], S[m8]);
        __builtin_amdgcn_sched_barrier(0);
      }
    }
  }
}

DI void phase_gdn_finalize(const Params& p) {
  const int tid = get_tid();
  const int gid = blockIdx.x * NTHREADS + tid;
  const int nth = gridDim.x * NTHREADS;
  const int l32 = tid & 31;
  for (int w = gid >> 5; w < NLAT * 4; w += nth >> 5) {
    int tok = w >> 2, head = w & 3;
    size_t off = (size_t)tok * 512 + head * 128 + l32 * 4;
    uint2 a = *(const uint2*)(p.gdn_of + off), bq = *(const uint2*)(p.gdn_ob + off);
    float v[4];
    v[0] = __uint_as_float(a.x << 16) + __uint_as_float(bq.x << 16);
    v[1] = __uint_as_float(a.x & 0xffff0000u) + __uint_as_float(bq.x & 0xffff0000u);
    v[2] = __uint_as_float(a.y << 16) + __uint_as_float(bq.y << 16);
    v[3] = __uint_as_float(a.y & 0xffff0000u) + __uint_as_float(bq.y & 0xffff0000u);
    float ss = v[0] * v[0] + v[1] * v[1] + v[2] * v[2] + v[3] * v[3];
#pragma unroll
    for (int o = 16; o >= 1; o >>= 1) ss += __shfl_xor(ss, o);
    float rstd = rsqrtf(ss * (1.f / 128.f) + 1e-6f);
    uint2 zq = *(const uint2*)(p.proj + (size_t)tok * LD1 + 1536 + head * 128 + l32 * 4);
    float z[4] = {__uint_as_float(zq.x << 16), __uint_as_float(zq.x & 0xffff0000u), __uint_as_float(zq.y << 16),
                  __uint_as_float(zq.y & 0xffff0000u)};
    float4 nw = *(const float4*)(p.gdn_norm_w + l32 * 4);
    uint2 o;
    o.x = pack2(v[0] * rstd * nw.x * siluf(z[0]), v[1] * rstd * nw.y * siluf(z[1]));
    o.y = pack2(v[2] * rstd * nw.z * siluf(z[2]), v[3] * rstd * nw.w * siluf(z[3]));
    *(uint2*)(p.mix + (size_t)tok * 1024 + head * 128 + l32 * 4) = o;
  }
}

DI int next_item(unsigned* counter, int* sslot) {
  __syncthreads();
  if (get_tid() == 0) *sslot = (int)atomicAdd(counter, 1u);
  __syncthreads();
  return *sslot;
}

DI void phase_mixer0(const Params& p, char* smem, int rep) {
  int* sslot = (int*)(smem + SMEM_BYTES - 16);
  float lam;
  {
    float s1 = 0.f, s2 = 0.f;
    for (int i = 0; i < 64; ++i) {
      s1 += p.diff_lambda[i] * p.diff_lambda[64 + i];
      s2 += p.diff_lambda[128 + i] * p.diff_lambda[192 + i];
    }
    lam = expf(s1) - expf(s2) + 0.2f;
  }
  const int NH = 256, NDL = NB * 4 * 32, NDC = NB * 4 * 4;
  while (true) {
    int item = next_item(p.counters + 0 + 2 * rep, sslot);
    if (item >= NH + NDL + NDC) break;
    if (item < NH) {
      hgrn_item(p, smem, item >> 3, item & 7);
    } else if (item < NH + NDL) {
      int i = item - NH;
      diff_item(p, smem, i >> 7, (i >> 5) & 3, i & 31, false, lam);
    } else {
      int i = item - NH - NDL;
      diff_item(p, smem, i >> 4, (i >> 2) & 3, i & 3, true, lam);
    }
  }
}

DI void phase_mixer1(const Params& p, char* smem, int rep) {
  int* sslot = (int*)(smem + SMEM_BYTES - 16);
  const int NG = 512, NS = NB * 8 * 32;
  while (true) {
    int item = next_item(p.counters + 1 + 2 * rep, sslot);
    if (item >= NG + NS) break;
    if (item < NG) {
      gdn_item(p, smem, item >> 4, (item >> 2) & 3, (item >> 1) & 1, item & 1);
    } else {
      int i = item - NG;
      swa_item(p, smem, i >> 8, (i >> 5) & 7, i & 31);
    }
  }
}

DI int quad_sum_i(int c) { return rows_sum_i(c); }
DI float quad_max_f(float v) { return rows_max(v); }
DI float quad_min_f(float v) { return rows_min(v); }
template <int NV>
DI float bisect16(const float (&v)[NV], float lo, float hi) {
  bool done = false;
  float tau = hi;
  for (int it = 0; it < 48; ++it) {
    float mid = 0.5f * (lo + hi);
    int c = 0;
#pragma unroll
    for (int k = 0; k < NV; ++k) c += (v[k] > mid) ? 1 : 0;
    c = quad_sum_i(c);
    if (!done) {
      if (c == 16) {
        done = true;
        tau = mid;
      } else if (c > 16) lo = mid;
      else hi = mid;
      if (!done) tau = hi;
    }
    if (__ballot(!done) == 0ull) break;
  }
  return tau;
}

DI void phase_topk(const Params& p, char* smem, int layer, int ntok) {
  const int tid0 = get_tid();
  const int nunits = (ntok / 16) * 2;
  for (int unit = blockIdx.x * 4 + (tid0 >> 6); unit < nunits; unit += gridDim.x * 4) {
    const int tok0 = (unit >> 1) * 16, hh = unit & 1;
    for (int h = hh * 4; h < hh * 4 + 4; ++h) {
      int tid = tid0;
      asm volatile("" : "+v"(tid));
      const int lane = tid & 63, wave = tid >> 6, q = lane >> 4, l15 = lane & 15;
      float* selV = (float*)smem + wave * 1536;
      int* selI = (int*)(selV + 512);
      float* outV = selV + 1024;
      int* outI = (int*)(selV + 1280);
      {
        f32x4 ninf = f32x4{-INFINITY, -INFINITY, -INFINITY, -INFINITY};
        u32x4 z = u32x4{0u, 0u, 0u, 0u};
        *(f32x4*)(selV + (l15 * 16) + q * 4) = ninf;
        *(f32x4*)(selV + 256 + (l15 * 16) + q * 4) = ninf;
        *(u32x4*)(selI + (l15 * 16) + q * 4) = z;
        *(u32x4*)(selI + 256 + (l15 * 16) + q * 4) = z;
        *(f32x4*)(outV + (l15 * 16) + q * 4) = ninf;
        *(u32x4*)(outI + (l15 * 16) + q * 4) = z;
      }
      float mx12[2], mn12[2];
#pragma unroll
      for (int pp = 0; pp < 2; ++pp) {
        const float* sp = p.pq + (size_t)(tok0 + l15) * 2048 + h * 256 + pp * 128 + q * 32;
        f32x4 sw[8];
#pragma unroll
        for (int i = 0; i < 8; ++i) sw[i] = *(const f32x4*)(sp + i * 4);
        float v[32];
        float mx = -INFINITY, mn = INFINITY;
#pragma unroll
        for (int i = 0; i < 8; ++i)
#pragma unroll
          for (int k = 0; k < 4; ++k) {
            v[i * 4 + k] = sw[i][k];
            mx = fmaxf(mx, sw[i][k]);
            mn = fminf(mn, sw[i][k]);
          }
        mx = quad_max_f(mx);
        mn = quad_min_f(mn);
        float tau = bisect16<32>(v, mn - 1.f, mx);
        int cl = 0;
#pragma unroll
        for (int k = 0; k < 32; ++k) cl += (v[k] > tau) ? 1 : 0;
        int c0 = __shfl(cl, l15), c1 = __shfl(cl, l15 + 16), c2 = __shfl(cl, l15 + 32);
        int slot = (q > 0 ? c0 : 0) + (q > 1 ? c1 : 0) + (q > 2 ? c2 : 0);
        float smin = INFINITY;
#pragma unroll
        for (int k = 0; k < 32; ++k) {
          if (v[k] > tau) {
            int sl = slot < 15 ? slot : 15;
            selV[pp * 256 + l15 * 16 + sl] = v[k];
            selI[pp * 256 + l15 * 16 + sl] = q * 32 + k;
            smin = fminf(smin, v[k]);
            slot++;
          }
        }
        mx12[pp] = mx;
        mn12[pp] = quad_min_f(smin);
      }
      __builtin_amdgcn_fence(__ATOMIC_RELEASE, "wavefront");
      __builtin_amdgcn_wave_barrier();
      float cand[64];
      int ai[4];
      {
        f32x4 a4 = *(const f32x4*)(selV + l15 * 16 + q * 4);
        u32x4 ai4 = *(const u32x4*)(selI + l15 * 16 + q * 4);
#pragma unroll
        for (int ii = 0; ii < 4; ++ii) ai[ii] = (int)ai4[ii];
#pragma unroll
        for (int j4 = 0; j4 < 4; ++j4) {
          f32x4 b4 = *(const f32x4*)(selV + 256 + l15 * 16 + j4 * 4);
#pragma unroll
          for (int ii = 0; ii < 4; ++ii)
#pragma unroll
            for (int jj = 0; jj < 4; ++jj) cand[ii * 16 + j4 * 4 + jj] = a4[ii] + b4[jj];
        }
      }
      const float m2 = mx12[0] + mx12[1];
      float lo2 = mn12[0] + mn12[1] - 1.f;
      if (!(lo2 > -1e30f)) lo2 = -1e30f;
      float tau2 = bisect16<64>(cand, lo2, m2);
      {
        int cl = 0;
#pragma unroll
        for (int k = 0; k < 64; ++k) cl += (cand[k] > tau2) ? 1 : 0;
        int c0 = __shfl(cl, l15), c1 = __shfl(cl, l15 + 16), c2 = __shfl(cl, l15 + 32);
        int slot = (q > 0 ? c0 : 0) + (q > 1 ? c1 : 0) + (q > 2 ? c2 : 0);
#pragma unroll
        for (int k = 0; k < 64; ++k) {
          if (cand[k] > tau2) {
            int sl = slot < 15 ? slot : 15;
            outV[l15 * 16 + sl] = cand[k];
            outI[l15 * 16 + sl] = ai[k >> 4] * 128 + selI[256 + l15 * 16 + (k & 15)];
            slot++;
          }
        }
      }
      __builtin_amdgcn_fence(__ATOMIC_RELEASE, "wavefront");
      __builtin_amdgcn_wave_barrier();
      {
        f32x4 v4 = *(const f32x4*)(outV + l15 * 16 + q * 4);
        u32x4 i4 = *(const u32x4*)(outI + l15 * 16 + q * 4);
        f32x4 e4;
        float ssum = 0.f;
#pragma unroll
        for (int k = 0; k < 4; ++k) {
          e4[k] = expf(v4[k] - m2);
          ssum += e4[k];
        }
        ssum = rows_sum(ssum);
        float inv = 1.f / ssum;
#pragma unroll
        for (int k = 0; k < 4; ++k) e4[k] *= inv;
        size_t o = (size_t)(tok0 + l15) * 128 + h * 16 + q * 4;
        *(u32x4*)(p.pidx + o) = i4;
        *(f32x4*)(p.pgate + o) = e4;
      }
      __builtin_amdgcn_wave_barrier();
    }
  }
}

DI void phase_experts_u(const Params& p, int layer, int ntok) {
  const int lane = get_tid() & 63, wave = get_tid() >> 6;
  const unsigned char* ub = p.u_q + (size_t)layer * 16384 * 1024;
  const float* usc = p.u_sc + layer * 16384;
  const float* vsc = p.v_sc + layer * 16384;
  for (int tok = blockIdx.x * 4 + wave; tok < ntok; tok += gridDim.x * 4) {
    const bf16_t* hrow = p.mix + (size_t)tok * 1024 + lane * 16;
    u32x4 xa = *(const u32x4*)hrow, xb = *(const u32x4*)(hrow + 8);
    float xf[16];
    float xs = 0.f;
#pragma unroll
    for (int k = 0; k < 4; ++k) {
      xf[2 * k] = __uint_as_float(xa[k] << 16);
      xf[2 * k + 1] = __uint_as_float(xa[k] & 0xffff0000u);
      xf[8 + 2 * k] = __uint_as_float(xb[k] << 16);
      xf[8 + 2 * k + 1] = __uint_as_float(xb[k] & 0xffff0000u);
    }
#pragma unroll
    for (int k = 0; k < 16; ++k) xs += xf[k];
    const float XS128 = 128.f * wave_sum(xs);
    int i0 = p.pidx[(size_t)tok * 128 + lane], i1 = p.pidx[(size_t)tok * 128 + 64 + lane];
    float g0 = p.pgate[(size_t)tok * 128 + lane], g1 = p.pgate[(size_t)tok * 128 + 64 + lane];
    constexpr int EU = 16;
    for (int e = 0; e < 128; e += EU) {
      u32x4 uq[EU];
#pragma unroll
      for (int u = 0; u < EU; ++u) {
        int ee = e + u;
        int row = __builtin_amdgcn_readlane(ee < 64 ? i0 : i1, ee & 63);
        uq[u] = *(const u32x4*)(ub + (size_t)row * 1024 + lane * 16);
      }
      const int esel = e + (lane & (EU - 1));
      const int myrow = __shfl(esel < 64 ? i0 : i1, esel & 63);
      const float mygate = __shfl(esel < 64 ? g0 : g1, esel & 63);
      const float mysu = usc[myrow], mysv = vsc[myrow];
      float d[EU];
#pragma unroll
      for (int u = 0; u < EU; ++u) {
        float sacc = 0.f;
#pragma unroll
        for (int k = 0; k < 4; ++k) {
          unsigned w = uq[u][k];
          sacc += xf[4 * k] * (float)(w & 0xffu);
          sacc += xf[4 * k + 1] * (float)((w >> 8) & 0xffu);
          sacc += xf[4 * k + 2] * (float)((w >> 16) & 0xffu);
          sacc += xf[4 * k + 3] * (float)(w >> 24);
        }
        d[u] = wave_sum(sacc);
      }
      float dsel = d[0];
#pragma unroll
      for (int u = 1; u < EU; ++u) dsel = ((lane & (EU - 1)) == u) ? d[u] : dsel;
      const float xd = mysu * (dsel - XS128);
      const float c2l = mygate * 0.5f * xd * (1.f + erff(xd * 0.7071067811865476f)) * mysv;
      if (lane < EU) p.pgate[(size_t)tok * 128 + e + lane] = c2l;
    }
  }
}

DI void phase_experts(const Params& p, int layer, int ntok, int dry) {
  const int lane = get_tid() & 63, wave = get_tid() >> 6;
  const unsigned char* vb = p.v_q + (size_t)layer * 16384 * 1024;
  for (int tok = blockIdx.x * 4 + wave; tok < ntok; tok += gridDim.x * 4) {
    int i0 = p.pidx[(size_t)tok * 128 + lane], i1 = p.pidx[(size_t)tok * 128 + 64 + lane];
    float g0 = p.pgate[(size_t)tok * 128 + lane], g1 = p.pgate[(size_t)tok * 128 + 64 + lane];
    float acc[16];
#pragma unroll
    for (int k = 0; k < 16; ++k) acc[k] = 0.f;
    float csum = 0.f;
    constexpr int EU = 16;
    for (int e = 0; e < 128; e += EU) {
      u32x4 vq[EU];
      float c2s[EU];
#pragma unroll
      for (int u = 0; u < EU; ++u) {
        int ee = e + u;
        int row = __builtin_amdgcn_readlane(ee < 64 ? i0 : i1, ee & 63);
        c2s[u] = __uint_as_float(__builtin_amdgcn_readlane(__float_as_uint(ee < 64 ? g0 : g1), ee & 63));
        vq[u] = *(const u32x4*)(vb + (size_t)row * 1024 + lane * 16);
      }
#pragma unroll
      for (int u = 0; u < EU; ++u) {
        const float c2 = c2s[u];
        csum += c2;
#pragma unroll
        for (int k = 0; k < 4; ++k) {
          unsigned w = vq[u][k];
          acc[4 * k] += c2 * (float)(w & 0xffu);
          acc[4 * k + 1] += c2 * (float)((w >> 8) & 0xffu);
          acc[4 * k + 2] += c2 * (float)((w >> 16) & 0xffu);
          acc[4 * k + 3] += c2 * (float)(w >> 24);
        }
      }
    }
#pragma unroll
    for (int k = 0; k < 16; ++k) acc[k] -= 128.f * csum;
    int vec = vec_of_row(tok);
    float* xr = tok < NLAT ? p.out + (size_t)tok * 1024 : p.xc + (size_t)(tok - NLAT) * 1024;
    const float* g2 = modp(p, layer, vec, 5);
    float xn[16];
    float ss = 0.f;
#pragma unroll
    for (int hlf = 0; hlf < 2; ++hlf) {
      int c0 = lane * 16 + hlf * 8;
      float4 a = *(const float4*)(xr + c0), bq = *(const float4*)(xr + c0 + 4);
      float4 ga = *(const float4*)(g2 + c0), gb = *(const float4*)(g2 + c0 + 4);
      float* o = xn + hlf * 8;
      o[0] = a.x + ga.x * acc[hlf * 8 + 0];
      o[1] = a.y + ga.y * acc[hlf * 8 + 1];
      o[2] = a.z + ga.z * acc[hlf * 8 + 2];
      o[3] = a.w + ga.w * acc[hlf * 8 + 3];
      o[4] = bq.x + gb.x * acc[hlf * 8 + 4];
      o[5] = bq.y + gb.y * acc[hlf * 8 + 5];
      o[6] = bq.z + gb.z * acc[hlf * 8 + 6];
      o[7] = bq.w + gb.w * acc[hlf * 8 + 7];
#pragma unroll
      for (int k = 0; k < 8; ++k) ss += o[k] * o[k];
    }
    ss = wave_sum(ss);
    float rstd = rsqrtf(ss * (1.f / 1024.f) + 1e-6f);
    if (dry && ss != -1.f) continue;
    if (layer == 0) {
      const float* nw = p.norm_w + (1 * 2 + 0) * 1024;
      const float* sh = modp(p, 1, vec, 0);
      const float* sc = modp(p, 1, vec, 1);
#pragma unroll
      for (int hlf = 0; hlf < 2; ++hlf) {
        int c0 = lane * 16 + hlf * 8;
        float* o = xn + hlf * 8;
        *(float4*)(xr + c0) = float4{o[0], o[1], o[2], o[3]};
        *(float4*)(xr + c0 + 4) = float4{o[4], o[5], o[6], o[7]};
        float hv[8];
#pragma unroll
        for (int k = 0; k < 8; ++k) hv[k] = o[k] * rstd * nw[c0 + k] * (1.f + sc[c0 + k]) + sh[c0 + k];
        uint4 w;
        w.x = pack2(hv[0], hv[1]);
        w.y = pack2(hv[2], hv[3]);
        w.z = pack2(hv[4], hv[5]);
        w.w = pack2(hv[6], hv[7]);
        *(uint4*)(p.mix + (size_t)tok * 1024 + c0) = w;
      }
    } else {
      const float* fw = p.final_norm_w;
#pragma unroll
      for (int hlf = 0; hlf < 2; ++hlf) {
        int c0 = lane * 16 + hlf * 8;
        float* o = xn + hlf * 8;
        float4 w0 = *(const float4*)(fw + c0), w1 = *(const float4*)(fw + c0 + 4);
        *(float4*)(xr + c0) = float4{o[0] * rstd * w0.x, o[1] * rstd * w0.y, o[2] * rstd * w0.z, o[3] * rstd * w0.w};
        *(float4*)(xr + c0 + 4) = float4{o[4] * rstd * w1.x, o[5] * rstd * w1.y, o[6] * rstd * w1.z, o[7] * rstd * w1.w};
      }
    }
  }
}

DI void run_phase(const Params& p, int ph, char* smem, int rep = 0) {
  switch (ph) {
    case 0: phase_setup(p, smem); break;
    case 1: phase_modulate(p, p.x, p.ctx, NTOK, 0, 0); break;
    case 2: phase_gemm<EPI_IN0>(p, p.mix, p.wt_in0, NTOK, 4096, smem, 0, nullptr, nullptr); break;
    case 3: phase_mixer0(p, smem, rep); break;
    case 4: phase_gemm<EPI_OUT>(p, p.mix, p.wt_out0, NTOK, 1024, smem, 0, p.x, p.ctx, rep); break;
    case 5: phase_modulate(p, p.out, p.xc, NTOK, 0, 1); break;
    case 6: phase_gemm<EPI_PQ>(p, p.mix, p.wt_q, NTOK, 2048, smem, 0, nullptr, nullptr); break;
    case 7: phase_topk(p, smem, 0, NTOK); break;
    case 8: phase_experts_u(p, 0, NTOK); break;
    case 9: phase_experts(p, 0, NTOK, rep); break;
    case 10: phase_gemm<EPI_IN1>(p, p.mix, p.wt_in1, NTOK, 2944, smem, 1, nullptr, nullptr); break;
    case 11: phase_mixer1(p, smem, rep); break;
    case 12: phase_gdn_finalize(p); break;
    case 13: phase_gemm<EPI_OUT>(p, p.mix, p.wt_out1, NLAT, 1024, smem, 1, p.out, p.xc, rep); break;
    case 14: phase_modulate(p, p.out, p.xc, NLAT, 1, 1); break;
    case 15: phase_gemm<EPI_PQ>(p, p.mix, p.wt_q + (size_t)2048 * 1024, NLAT, 2048, smem, 1, nullptr, nullptr); break;
    case 16: phase_topk(p, smem, 1, NLAT); break;
    case 17: phase_experts_u(p, 1, NLAT); break;
    case 18: phase_experts(p, 1, NLAT, rep); break;
  }
}

#define XB_TMO      128
#define XB_XCNT(j)  (256  + 64 * (j))
#define XB_XSUB(j)  (1280 + 64 * (j))
#define XB_XGEN(j)  (2304 + 64 * (j))
#define XB_TOP      3328
#define XB_TOPGEN   3392
#define XCD_BAR_WORDS 3456
#define XB_SPIN_CAP (1u << 18)
#define LAS __attribute__((address_space(3)))

__device__ __forceinline__ unsigned xb_ld(unsigned* p)              { return __hip_atomic_load(p, __ATOMIC_RELAXED, __HIP_MEMORY_SCOPE_AGENT); }
__device__ __forceinline__ unsigned xb_add(unsigned* p, unsigned v) { return __hip_atomic_fetch_add(p, v, __ATOMIC_RELAXED, __HIP_MEMORY_SCOPE_AGENT); }
__device__ __forceinline__ unsigned xb_xcc_id() { return (unsigned)__builtin_amdgcn_s_getreg((3 << 11) | 20) & 0xFu; }
#define XB_SPIN(cond, bar) do { unsigned _sp = 0; while (cond) { __builtin_amdgcn_s_sleep(1); \
    if ((++_sp & 255u) == 0u) { if (xb_ld(&(bar)[XB_TMO])) break; if (_sp > XB_SPIN_CAP) { atomicAdd(&(bar)[XB_TMO], 1u); break; } } } } while (0)

struct XcdBarrier {
    unsigned* bar; unsigned x;
    volatile LAS unsigned* st;
};

__device__ __forceinline__ XcdBarrier xcd_barrier_post(unsigned* bar, volatile LAS unsigned* st) {
    XcdBarrier b; b.bar = bar; b.x = xb_xcc_id(); b.st = st;
    if (threadIdx.x == 0) (void)xb_add(&bar[XB_XCNT(b.x)], 1u);
    return b;
}
__device__ __forceinline__ void xcd_barrier_complete(unsigned* bar, unsigned x, unsigned& nloc, unsigned& nx) {
    const unsigned G = gridDim.x * gridDim.y * gridDim.z;
    unsigned sum, cnt, mine, sp = 0u;
    for (;;) {
        sum = 0u; cnt = 0u; mine = 0u;
#pragma unroll
        for (unsigned j = 0; j < 16; ++j) { const unsigned c = xb_ld(&bar[XB_XCNT(j)]); sum += c; cnt += (c > 0u) ? 1u : 0u; mine = (j == x) ? c : mine; }
        if (sum == G) break;
        __builtin_amdgcn_s_sleep(1);
        if ((++sp & 255u) == 0u) { if (xb_ld(&bar[XB_TMO])) break; if (sp > XB_SPIN_CAP) { atomicAdd(&bar[XB_TMO], 1u); break; } }
    }
    nloc = mine > 0u ? mine : 1u; nx = cnt > 0u ? cnt : 1u;
}

__device__ __forceinline__ void xcd_barrier(const XcdBarrier& b) {
    asm volatile("s_waitcnt vmcnt(0)" ::: "memory");
    __syncthreads();
    if (threadIdx.x == 0) {
        unsigned* bar = b.bar;
        __builtin_amdgcn_s_waitcnt(0);
        unsigned nloc = b.st[0], nx = b.st[1];
        if (nloc == 0u) { xcd_barrier_complete(bar, b.x, nloc, nx); b.st[0] = nloc; b.st[1] = nx; }
        const unsigned old = xb_add(&bar[XB_XSUB(b.x)], 1u);
        const unsigned gen = old / nloc;
        if (old + 1u == (gen + 1u) * nloc) {
            __builtin_amdgcn_fence(__ATOMIC_RELEASE, "agent");
            asm volatile("s_waitcnt vmcnt(0)" ::: "memory");
            const unsigned og = xb_add(&bar[XB_TOP], 1u);
            const unsigned tg = og / nx;
            if (og + 1u == (tg + 1u) * nx) xb_add(&bar[XB_TOPGEN], 1u);
            else XB_SPIN(xb_ld(&bar[XB_TOPGEN]) == tg, bar);
            __builtin_amdgcn_fence(__ATOMIC_ACQUIRE, "agent");
            xb_add(&bar[XB_XGEN(b.x)], 1u);
            asm volatile("s_waitcnt vmcnt(0)" ::: "memory");
        } else {
            XB_SPIN(xb_ld(&bar[XB_XGEN(b.x)]) == gen, bar);
            __builtin_amdgcn_fence(__ATOMIC_ACQUIRE, "agent");
            asm volatile("s_waitcnt vmcnt(0)" ::: "memory");
        }
    }
    __syncthreads();
}


#if SINGLE_LAUNCH
__global__ void __launch_bounds__(NTHREADS, 2) mega_kernel(Params p, int ph_lo, int ph_hi) {
  __shared__ __attribute__((aligned(16))) char smem[SMEM_BYTES];
  __shared__ uint4 xb_words;
  if (threadIdx.x == 0) xb_words = make_uint4(0u, 0u, 0u, 0u);
  __syncthreads();
  XcdBarrier xb = xcd_barrier_post(p.xbar, (volatile LAS unsigned*)&xb_words);
#ifdef PROBE_A
  unsigned long long* tstamp = (unsigned long long*)(p.counters + 16);
#endif
  for (int ph = ph_lo; ph < ph_hi; ++ph) {
    if (ph > ph_lo) {
      if (ph == ph_lo + 1) cg::this_grid().sync();
      else xcd_barrier(xb);
    }
#ifdef PROBE_A
    if (blockIdx.x == 0 && threadIdx.x == 0) tstamp[ph] = wall_clock64();
#endif
    run_phase(p, ph, smem);
#ifdef REPEAT_MASK
    if ((REPEAT_MASK >> ph) & 1) {
      cg::this_grid().sync();
      run_phase(p, ph, smem, 1);
    }
#endif
  }
#ifdef PROBE_A
  cg::this_grid().sync();
  if (blockIdx.x == 0) {
    if (threadIdx.x == 0) tstamp[NPHASES] = wall_clock64();
    __syncthreads();
    float A = 0.f, B = 0.f;
    for (int ph = 0; ph < NPHASES; ++ph) {
      float d = (float)(tstamp[ph + 1] - tstamp[ph]) * 0.01f;
      if ((PROBE_A >> ph) & 1) A += d;
      if ((PROBE_B >> ph) & 1) B += d;
    }
    for (int i = threadIdx.x; i < 65536; i += NTHREADS) p.out[1024 + i] += B;
    if (threadIdx.x == 0) p.out[0] += A;
  }
#endif
}
#define OCC_KERNEL mega_kernel
#else
template <int PH>
__global__ void __launch_bounds__(NTHREADS, (PH == 10 ? 1 : 2)) phase_kernel(Params p) {
  __shared__ __attribute__((aligned(16))) char smem[SMEM_BYTES];
  run_phase(p, PH, smem);
}
#define OCC_KERNEL phase_kernel<3>
template <int PH>
static void launch_phases(const Params& p, int grid, hipStream_t stream) {
  hipLaunchKernelGGL(phase_kernel<PH>, dim3(grid), dim3(NTHREADS), 0, stream, p);
  if constexpr (PH + 1 < NPHASES) launch_phases<PH + 1>(p, grid, stream);
}
#endif

extern "C" void kernel_launch(void* const* d_in, const int* in_sizes, int n_in, void* d_out, int out_size, void* d_ws,
                              size_t ws_size, hipStream_t stream) {
  static int grid_blocks = 0;
  if (!grid_blocks) {
    int dev = 0, cus = 0, per_cu = 0;
    (void)hipGetDevice(&dev);
    (void)hipDeviceGetAttribute(&cus, hipDeviceAttributeMultiprocessorCount, dev);
    (void)hipOccupancyMaxActiveBlocksPerMultiprocessor(&per_cu, OCC_KERNEL, NTHREADS, 0);
    if (per_cu < 1) per_cu = 1;
    if (per_cu > 2) per_cu = 2;
    grid_blocks = cus * per_cu;
  }
  Params p{};
  const float** fp = (const float**)&p;
  for (int i = 0; i < 25; ++i) fp[i] = (const float*)d_in[i];
  p.out = (float*)d_out;
  char* ws = (char*)d_ws;
  size_t off = 0;
  auto take = [&](size_t bytes) { char* r = ws + off; off += (bytes + 255) & ~(size_t)255; return r; };
  p.proj = (bf16_t*)take((size_t)NTOK * LD0 * 2);
  p.mix = (bf16_t*)take((size_t)NTOK * 1024 * 2);
  p.xc = (float*)take((size_t)NCTX * 1024 * 4);
  p.mod = (float*)take((size_t)2 * 33 * 6144 * 4);
  p.rope = (float*)take(64 * 16 * 2 * 4);
  p.wt_in0 = (bf16_t*)take((size_t)4096 * 1024 * 2);
  p.wt_out0 = (bf16_t*)take((size_t)1024 * 1024 * 2);
  p.wt_in1 = (bf16_t*)take((size_t)2944 * 1024 * 2);
  p.wt_out1 = (bf16_t*)take((size_t)1024 * 1024 * 2);
  p.wt_q = (bf16_t*)take((size_t)2 * 2048 * 1024 * 2);
  p.keys_bf = (bf16_t*)take((size_t)2 * 8 * 2 * 128 * 128 * 2);
  p.u_q = (unsigned char*)take((size_t)2 * 16384 * 1024);
  p.v_q = (unsigned char*)take((size_t)2 * 16384 * 1024);
  p.u_sc = (float*)take((size_t)2 * 16384 * 4);
  p.v_sc = (float*)take((size_t)2 * 16384 * 4);
  p.counters = (unsigned*)take(256);
  p.xbar = (unsigned*)take((size_t)XCD_BAR_WORDS * 4);
  p.pq = (float*)p.proj;
  p.pidx = (int*)take((size_t)NTOK * 128 * 4);
  p.pgate = (float*)take((size_t)NTOK * 128 * 4);
  p.gdn_of = (bf16_t*)((char*)p.proj + (size_t)NTOK * LD1 * 2);
  p.gdn_ob = p.gdn_of + (size_t)NLAT * 512;
  if (off > ws_size) fprintf(stderr, "workspace too small: need %zu have %zu\n", off, ws_size);
  (void)hipMemsetAsync(p.counters, 0, 256 + (size_t)XCD_BAR_WORDS * 4, stream);
#if SINGLE_LAUNCH
  int lo = 0, hi = NPHASES;
  void* args[] = {&p, &lo, &hi};
  hipError_t e = hipLaunchCooperativeKernel((void*)mega_kernel, dim3(grid_blocks), dim3(NTHREADS), args, 0, stream);
  if (e != hipSuccess) fprintf(stderr, "cooperative launch failed: %s (grid %d)\n", hipGetErrorString(e), grid_blocks);
#else
  launch_phases<0>(p, grid_blocks, stream);
#endif
}
```

```cpp
#include <hip/hip_runtime.h>
#include <hip/hip_cooperative_groups.h>
#include <cstdio>
#include <type_traits>
namespace cg = cooperative_groups;

#ifndef SINGLE_LAUNCH
#define SINGLE_LAUNCH 1
#endif

typedef unsigned short bf16_t;
using bf16x8 = __attribute__((ext_vector_type(8))) short;
using s16x4 = __attribute__((ext_vector_type(4))) short;
using f32x4 = __attribute__((ext_vector_type(4))) float;
using u32x4 = __attribute__((ext_vector_type(4))) unsigned;
typedef __attribute__((ext_vector_type(2))) __bf16 bf2_t;
#define DI __device__ __forceinline__

constexpr int NB = 32, TT = 2048, LL = 256, DM = 1024;
constexpr int NLAT = NB * TT, NCTX = NB * LL, NTOK = NLAT + NCTX;
constexpr int LD0 = 4096, LD1 = 2944;
constexpr int SMEM_BYTES = 79360;
constexpr int NTHREADS = 256;
constexpr int NPHASES = 19;

struct Params {
  const float *x, *c, *ctx, *c_ctx, *ada_w, *ada_b, *norm_w, *final_norm_w, *even_w_in, *even_w_out, *diff_lambda,
      *diff_subln_w, *hgrn_lb, *hgrn_norm_w, *odd_w_in, *odd_w_out, *gdn_conv_w, *gdn_a_log, *gdn_dt_bias, *gdn_norm_w,
      *swa_sink, *peer_w_q, *peer_keys, *peer_u, *peer_v;
  float* out;
  bf16_t *proj, *mix, *wt_in0, *wt_out0, *wt_in1, *wt_out1, *wt_q, *keys_bf, *gdn_of, *gdn_ob;
  float* pq;
  unsigned char *u_q, *v_q;
  float *u_sc, *v_sc;
  float *xc, *mod, *rope, *pgate;
  int* pidx;
  unsigned* counters;
  unsigned* xbar;
};

DI int get_tid() {
  int t = threadIdx.x;
  asm volatile("" : "+v"(t));
  return t;
}
DI bf16_t f2bf(float x) { return __builtin_bit_cast(unsigned short, (__bf16)x); }
DI float bf2f(bf16_t h) { return __uint_as_float(((unsigned)h) << 16); }
DI unsigned pack2(float a, float b) {
  typedef __attribute__((ext_vector_type(2))) float f32x2_t;
  f32x2_t v = {a, b};
  return __builtin_bit_cast(unsigned, __builtin_convertvector(v, bf2_t));
}
DI f32x4 mfma16(bf16x8 a, bf16x8 b, f32x4 c) { return __builtin_amdgcn_mfma_f32_16x16x32_bf16(a, b, c, 0, 0, 0); }
DI bf16x8 ldfrag(const bf16_t* p) { return *(const bf16x8*)p; }
DI bf16x8 ldfrag_perm(const bf16_t* row, int ks, int q) {
  s16x4 lo = *(const s16x4*)(row + ks * 32 + q * 4);
  s16x4 hi = *(const s16x4*)(row + ks * 32 + 16 + q * 4);
  return __builtin_shufflevector(lo, hi, 0, 1, 2, 3, 4, 5, 6, 7);
}
DI bf16x8 packfrag(f32x4 a, f32x4 b) {
  unsigned w0 = pack2(a[0], a[1]), w1 = pack2(a[2], a[3]), w2 = pack2(b[0], b[1]), w3 = pack2(b[2], b[3]);
  typedef __attribute__((ext_vector_type(4))) unsigned u32x4;
  u32x4 v = {w0, w1, w2, w3};
  return __builtin_bit_cast(bf16x8, v);
}
DI float siluf(float x) { return x / (1.f + expf(-x)); }
DI float silu_fast(float x) { return __fdividef(x, 1.f + __expf(-x)); }
DI float sigmoidf_(float x) { return 1.f / (1.f + expf(-x)); }
template <int N>
DI float dpp_ror(float v) {
  return __builtin_bit_cast(float, __builtin_amdgcn_update_dpp(0, __builtin_bit_cast(int, v), 0x120 + N, 0xf, 0xf, false));
}
DI float grp16_sum(float v) {
  v += dpp_ror<8>(v);
  v += dpp_ror<4>(v);
  v += dpp_ror<2>(v);
  v += dpp_ror<1>(v);
  return v;
}
DI float grp16_max(float v) {
  v = fmaxf(v, dpp_ror<8>(v));
  v = fmaxf(v, dpp_ror<4>(v));
  v = fmaxf(v, dpp_ror<2>(v));
  v = fmaxf(v, dpp_ror<1>(v));
  return v;
}
DI float rows_sum(float v) {
  auto a = __builtin_amdgcn_permlane16_swap(__float_as_uint(v), __float_as_uint(v), false, false);
  v = __uint_as_float(a[0]) + __uint_as_float(a[1]);
  auto b = __builtin_amdgcn_permlane32_swap(__float_as_uint(v), __float_as_uint(v), false, false);
  return __uint_as_float(b[0]) + __uint_as_float(b[1]);
}
DI float rows_max(float v) {
  auto a = __builtin_amdgcn_permlane16_swap(__float_as_uint(v), __float_as_uint(v), false, false);
  v = fmaxf(__uint_as_float(a[0]), __uint_as_float(a[1]));
  auto b = __builtin_amdgcn_permlane32_swap(__float_as_uint(v), __float_as_uint(v), false, false);
  return fmaxf(__uint_as_float(b[0]), __uint_as_float(b[1]));
}
DI float rows_min(float v) {
  auto a = __builtin_amdgcn_permlane16_swap(__float_as_uint(v), __float_as_uint(v), false, false);
  v = fminf(__uint_as_float(a[0]), __uint_as_float(a[1]));
  auto b = __builtin_amdgcn_permlane32_swap(__float_as_uint(v), __float_as_uint(v), false, false);
  return fminf(__uint_as_float(b[0]), __uint_as_float(b[1]));
}
DI int rows_sum_i(int v) {
  auto a = __builtin_amdgcn_permlane16_swap((unsigned)v, (unsigned)v, false, false);
  v = (int)(a[0] + a[1]);
  auto b = __builtin_amdgcn_permlane32_swap((unsigned)v, (unsigned)v, false, false);
  return (int)(b[0] + b[1]);
}
DI float wave_sum(float v) { return rows_sum(grp16_sum(v)); }
DI const float* modp(const Params& p, int layer, int vec, int chunk) {
  return p.mod + ((size_t)(layer * 33 + vec) * 6 + chunk) * 1024;
}
DI int vec_of_row(int row) { return row < NLAT ? (row >> 11) : 32; }

DI void transpose_job(const float* W, int nsrc, bf16_t* Wt, int n0, int k0, int mapmode, float* tile) {
  const int tid = get_tid();
  __syncthreads();
#pragma unroll 4
  for (int i = 0; i < 16; ++i) {
    int kk = (tid >> 6) + 4 * i, nn = tid & 63;
    int nd = n0 + nn, ns = nd;
    if (mapmode == 1) ns = nd < 2048 ? nd : (nd < 2816 ? nd + 16 : (nd < 2832 ? nd - 768 : -1));
    float v = ns >= 0 ? W[(size_t)(k0 + kk) * nsrc + ns] : 0.f;
    tile[kk * 65 + nn] = v;
  }
  __syncthreads();
#pragma unroll 4
  for (int i = 0; i < 16; ++i) {
    int nn = (tid >> 6) + 4 * i, kk = tid & 63;
    Wt[(size_t)(n0 + nn) * 1024 + k0 + kk] = f2bf(tile[kk * 65 + nn]);
  }
}

DI void convert_seg(const float* src, bf16_t* dst, size_t n4) {
  size_t stride = (size_t)gridDim.x * NTHREADS;
  for (size_t i = (size_t)blockIdx.x * NTHREADS + get_tid(); i < n4; i += stride) {
    float4 v = ((const float4*)src)[i];
    uint2 o;
    o.x = pack2(v.x, v.y);
    o.y = pack2(v.z, v.w);
    ((uint2*)dst)[i] = o;
  }
}

DI int setup_next_item(unsigned* counter, int* sslot) {
  __syncthreads();
  if (get_tid() == 0) *sslot = (int)atomicAdd(counter, 1u);
  __syncthreads();
  return *sslot;
}

DI void phase_setup(const Params& p, char* smem) {
  const int tid = get_tid();
  float* sm = (float*)smem;
  int* sslot = (int*)(smem + SMEM_BYTES - 16);
  for (int i = blockIdx.x * NTHREADS + tid; i < 64 * 16; i += gridDim.x * NTHREADS) {
    int pos = i >> 4, f = i & 15;
    float inv = powf(10000.f, -(float)f / 16.f);
    float ang = (float)pos * inv;
    p.rope[i * 2] = cosf(ang);
    p.rope[i * 2 + 1] = sinf(ang);
  }
  const int NA = 192, J0 = 1024, J1 = J0 + 256, J2 = J1 + 736, J3 = J2 + 256, J4 = J3 + 512, NQI = 2048;
  while (true) {
    const int item = setup_next_item(p.counters + 8, sslot);
    if (item >= NA + J4 + NQI) break;
    if (item < NA) {
      const int job = item;
    int layer = job / 96, col0 = (job % 96) * 64;
    float acc[33];
#pragma unroll
    for (int v = 0; v < 33; ++v) acc[v] = 0.f;
    float* sc = sm;
    float* red = sm + 33 * 256;
    const int col = col0 + (tid & 63), kq = tid >> 6;
    for (int kc = 0; kc < 4; ++kc) {
      __syncthreads();
      for (int idx = tid; idx < 33 * 256; idx += NTHREADS) {
        int v = idx >> 8, kk = idx & 255, k = kc * 256 + kk;
        float cv = v < 32 ? p.c[v * 1024 + k] : p.c_ctx[k];
        sc[idx] = siluf(cv);
      }
      __syncthreads();
#pragma unroll 8
      for (int kk = kq * 64; kk < kq * 64 + 64; ++kk) {
        float w = p.ada_w[((size_t)layer * 1024 + kc * 256 + kk) * 6144 + col];
#pragma unroll
        for (int v = 0; v < 33; ++v) acc[v] += sc[v * 256 + kk] * w;
      }
    }
    __syncthreads();
#pragma unroll
    for (int v = 0; v < 33; ++v) red[(kq * 33 + v) * 64 + (tid & 63)] = acc[v];
    __syncthreads();
    for (int idx = tid; idx < 33 * 64; idx += NTHREADS) {
      int v = idx >> 6, cc = idx & 63;
      float s = p.ada_b[layer * 6144 + col0 + cc];
#pragma unroll
      for (int k4 = 0; k4 < 4; ++k4) s += red[(k4 * 33 + v) * 64 + cc];
      p.mod[(size_t)(layer * 33 + v) * 6144 + col0 + cc] = s;
    }
    __syncthreads();
    } else if (item < NA + J4) {
      const int job = item - NA;
      if (job < J0) {
        transpose_job(p.even_w_in, 4096, p.wt_in0, (job >> 4) * 64, (job & 15) * 64, 0, sm);
      } else if (job < J1) {
        int j = job - J0;
        transpose_job(p.even_w_out, 1024, p.wt_out0, (j >> 4) * 64, (j & 15) * 64, 0, sm);
      } else if (job < J2) {
        int j = job - J1;
        transpose_job(p.odd_w_in, 2832, p.wt_in1, (j >> 4) * 64, (j & 15) * 64, 1, sm);
      } else if (job < J3) {
        int j = job - J2;
        transpose_job(p.odd_w_out, 1024, p.wt_out1, (j >> 4) * 64, (j & 15) * 64, 0, sm);
      } else {
        int j = job - J3;
        const int layer = j >> 8, hp = (j >> 4) & 15, kt = j & 15;
        const int lane = tid & 63, wave = tid >> 6, q = lane >> 4, l15 = lane & 15;
        const float* wq = p.peer_w_q + ((size_t)layer * 1024 + kt * 64 + wave * 16 + l15) * 2048 + hp * 128;
        const float* ky = p.peer_keys + ((size_t)(layer * 16 + hp) * 128) * 128;
        f32x4 acc[8];
#pragma unroll
        for (int nt = 0; nt < 8; ++nt) acc[nt] = f32x4{0.f, 0.f, 0.f, 0.f};
#pragma unroll
        for (int ks = 0; ks < 4; ++ks) {
          f32x4 a0 = *(const f32x4*)(wq + ks * 32 + q * 8), a1 = *(const f32x4*)(wq + ks * 32 + q * 8 + 4);
          bf16x8 af = packfrag(a0, a1);
#pragma unroll
          for (int nt = 0; nt < 8; ++nt) {
            const float* kp = ky + (size_t)(nt * 16 + l15) * 128 + ks * 32 + q * 8;
            f32x4 b0 = *(const f32x4*)kp, b1 = *(const f32x4*)(kp + 4);
            acc[nt] = mfma16(af, packfrag(b0, b1), acc[nt]);
          }
        }
#pragma unroll
        for (int nt = 0; nt < 8; ++nt) {
          uint2 ov;
          ov.x = pack2(acc[nt][0], acc[nt][1]);
          ov.y = pack2(acc[nt][2], acc[nt][3]);
          *(uint2*)(p.wt_q + (size_t)layer * 2048 * 1024 + (size_t)(hp * 128 + nt * 16 + l15) * 1024 + kt * 64 + wave * 16 + q * 4) = ov;
        }
      }
    } else {
      const int lane = tid & 63, wave = tid >> 6;
      const int row0 = (item - NA - J4) * 32 + wave * 8;
#pragma unroll 1
      for (int rb = 0; rb < 8; rb += 4) {
        f32x4 v[4][4];
#pragma unroll
        for (int rr = 0; rr < 4; ++rr) {
          const int row = row0 + rb + rr;
          const int tab = row >> 15, r = row & 32767;
          const float* src = (tab == 0 ? p.peer_u : p.peer_v) + (size_t)r * 1024 + lane * 16;
#pragma unroll
          for (int i = 0; i < 4; ++i) v[rr][i] = *(const f32x4*)(src + i * 4);
        }
#pragma unroll
        for (int rr = 0; rr < 4; ++rr) {
          const int row = row0 + rb + rr;
          const int tab = row >> 15, r = row & 32767;
          float mx = 0.f;
#pragma unroll
          for (int i = 0; i < 4; ++i)
#pragma unroll
            for (int k = 0; k < 4; ++k) mx = fmaxf(mx, fabsf(v[rr][i][k]));
          mx = rows_max(grp16_max(mx));
          float sc = mx > 0.f ? mx * (1.f / 127.f) : 1.f;
          float inv = 1.f / sc;
          u32x4 o;
#pragma unroll
          for (int i = 0; i < 4; ++i) {
            unsigned w = 0;
#pragma unroll
            for (int k = 0; k < 4; ++k) {
              float qf = rintf(v[rr][i][k] * inv);
              qf = fminf(fmaxf(qf, -127.f), 127.f);
              w |= ((unsigned)((int)qf + 128)) << (8 * k);
            }
            o[i] = w;
          }
          *(u32x4*)((tab == 0 ? p.u_q : p.v_q) + (size_t)r * 1024 + lane * 16) = o;
          if (lane == 0) (tab == 0 ? p.u_sc : p.v_sc)[r] = sc;
        }
      }
    }
  }
}

DI void phase_modulate(const Params& p, const float* xlat, const float* xctx, int nrows, int layer, int which) {
  const int lane = get_tid() & 63, wave = get_tid() >> 6;
  const float* nw = p.norm_w + (layer * 2 + which) * 1024;
  for (int row = blockIdx.x * 4 + wave; row < nrows; row += gridDim.x * 4) {
    const float* xr = row < NLAT ? xlat + (size_t)row * 1024 : xctx + (size_t)(row - NLAT) * 1024;
    int vec = vec_of_row(row);
    const float* sh = modp(p, layer, vec, which * 3 + 0);
    const float* sc = modp(p, layer, vec, which * 3 + 1);
    f32x4 v[4];
    float ss = 0.f;
#pragma unroll
    for (int i = 0; i < 4; ++i) {
      v[i] = *(const f32x4*)(xr + i * 256 + lane * 4);
      ss += v[i][0] * v[i][0] + v[i][1] * v[i][1] + v[i][2] * v[i][2] + v[i][3] * v[i][3];
    }
    ss = wave_sum(ss);
    float rstd = rsqrtf(ss * (1.f / 1024.f) + 1e-6f);
#pragma unroll
    for (int i = 0; i < 4; ++i) {
      int c0 = i * 256 + lane * 4;
      float4 w = *(const float4*)(nw + c0), s1 = *(const float4*)(sc + c0), s0 = *(const float4*)(sh + c0);
      float a = v[i][0] * rstd * w.x * (1.f + s1.x) + s0.x;
      float b = v[i][1] * rstd * w.y * (1.f + s1.y) + s0.y;
      float c = v[i][2] * rstd * w.z * (1.f + s1.z) + s0.z;
      float d = v[i][3] * rstd * w.w * (1.f + s1.w) + s0.w;
      uint2 o;
      o.x = pack2(a, b);
      o.y = pack2(c, d);
      *(uint2*)(p.mix + (size_t)row * 1024 + c0) = o;
    }
  }
}

enum { EPI_IN0 = 0, EPI_IN1 = 1, EPI_OUT = 2, EPI_PQ = 3 };
template <int EPI>
DI void phase_gemm(const Params& p, const bf16_t* A, const bf16_t* Bt, int M, int N, char* smem, int layer,
                           const float* xin_lat, const float* xin_ctx, int dry = 0) {
  constexpr int MI = 8;
  bf16_t* sbase = (bf16_t*)smem;
  const int tid = get_tid(), lane = tid & 63, wave = tid >> 6, q = lane >> 4, l15 = lane & 15;
  const int wm = wave >> 1, wn = wave & 1;
  const int ntn = N / 128, ntm = M / 256;
  const int lr = tid >> 2, lc = (tid & 3) * 8;
  const int xcd = blockIdx.x & 7, lcl = blockIdx.x >> 3, nl = gridDim.x >> 3;
  const int ngn = (ntn + 7) >> 3, ngm = (ntm + 7) >> 3;
  for (int wi = lcl; wi < ((ngn * ngm + 7) >> 3) * 64; wi += nl) {
    const int sid = (wi >> 6) * 8 + xcd, within = wi & 63;
    if (sid >= ngn * ngm) continue;
    const int tm = (sid / ngn) * 8 + (within >> 3), tn = (sid % ngn) * 8 + (within & 7);
    if (tm >= ntm || tn >= ntn) continue;
    f32x4 acc[MI][4];
#pragma unroll
    for (int i = 0; i < MI; ++i)
#pragma unroll
      for (int j = 0; j < 4; ++j) acc[i][j] = f32x4{0.f, 0.f, 0.f, 0.f};
    const bf16_t* Ag = A + (size_t)(tm * 256 + lr) * 1024 + lc;
    const bf16_t* Bg = Bt + (size_t)(tn * 128 + lr) * 1024 + lc;
    u32x4 ra[4], rb[2];
#pragma unroll
    for (int i = 0; i < 4; ++i) ra[i] = *(const u32x4*)(Ag + (size_t)i * 64 * 1024);
#pragma unroll
    for (int i = 0; i < 2; ++i) rb[i] = *(const u32x4*)(Bg + (size_t)i * 64 * 1024);
    __syncthreads();
    for (int kt = 0; kt < 32; ++kt) {
      bf16_t* cA = sbase + (kt & 1) * (384 * 48);
      bf16_t* cB = cA + 256 * 48;
#pragma unroll
      for (int i = 0; i < 4; ++i) *(u32x4*)(cA + (lr + 64 * i) * 48 + lc) = ra[i];
#pragma unroll
      for (int i = 0; i < 2; ++i) *(u32x4*)(cB + (lr + 64 * i) * 48 + lc) = rb[i];
      __syncthreads();
      if (kt + 1 < 32) {
#pragma unroll
        for (int i = 0; i < 4; ++i) ra[i] = *(const u32x4*)(Ag + (size_t)i * 64 * 1024 + (kt + 1) * 32);
#pragma unroll
        for (int i = 0; i < 2; ++i) rb[i] = *(const u32x4*)(Bg + (size_t)i * 64 * 1024 + (kt + 1) * 32);
      }
      bf16x8 bfr[4];
#pragma unroll
      for (int j = 0; j < 4; ++j) bfr[j] = ldfrag(cB + (wn * 64 + j * 16 + l15) * 48 + q * 8);
#pragma unroll
      for (int i = 0; i < MI; ++i) {
        bf16x8 af = ldfrag(cA + (wm * 128 + i * 16 + l15) * 48 + q * 8);
#pragma unroll
        for (int j = 0; j < 4; ++j) acc[i][j] = mfma16(bfr[j], af, acc[i][j]);
      }
    }
    const int colbase = tn * 128 + wn * 64;
    const int rowbase = tm * 256 + wm * 128;
    if (EPI == EPI_IN0 || EPI == EPI_IN1) {
      const int ld = EPI == EPI_IN0 ? LD0 : LD1;
      bool ropegrp = EPI == EPI_IN0 ? (colbase < 1024) : (colbase >= 2048 && colbase < 2688);
      bool lat = rowbase < NLAT;
      if (ropegrp && lat) {
#pragma unroll
        for (int i = 0; i < MI; ++i) {
          int row = rowbase + i * 16 + l15;
          int t = row & 2047, gr = t >> 6, gc = t & 63;
          const f32x4* pr = (const f32x4*)(p.rope + (gr * 16 + q * 4) * 2);
          const f32x4* pc = (const f32x4*)(p.rope + (gc * 16 + q * 4) * 2);
          f32x4 r0 = pr[0], r1 = pr[1], c0 = pc[0], c1 = pc[1];
          float crc[4] = {r0[0], r0[2], r1[0], r1[2]}, crs[4] = {r0[1], r0[3], r1[1], r1[3]};
          float ccc[4] = {c0[0], c0[2], c1[0], c1[2]}, ccs[4] = {c0[1], c0[3], c1[1], c1[3]};
          float o1[4], o2[4], o3[4], o4[4];
#pragma unroll
          for (int r = 0; r < 4; ++r) {
            float x1 = acc[i][0][r], x2 = acc[i][1][r], x3 = acc[i][2][r], x4 = acc[i][3][r];
            o1[r] = x1 * crc[r] - x2 * crs[r];
            o2[r] = x2 * crc[r] + x1 * crs[r];
            o3[r] = x3 * ccc[r] - x4 * ccs[r];
            o4[r] = x4 * ccc[r] + x3 * ccs[r];
          }
          bf16_t* o = p.proj + (size_t)row * ld + colbase + q * 4;
          *(uint2*)(o) = uint2{pack2(o1[0], o1[1]), pack2(o1[2], o1[3])};
          *(uint2*)(o + 16) = uint2{pack2(o2[0], o2[1]), pack2(o2[2], o2[3])};
          *(uint2*)(o + 32) = uint2{pack2(o3[0], o3[1]), pack2(o3[2], o3[3])};
          *(uint2*)(o + 48) = uint2{pack2(o4[0], o4[1]), pack2(o4[2], o4[3])};
        }
      } else {
#pragma unroll
        for (int i = 0; i < MI; ++i) {
          int row = rowbase + i * 16 + l15;
#pragma unroll
          for (int j = 0; j < 4; ++j) {
            int col = colbase + j * 16 + q * 4;
            if (EPI == EPI_IN0 || col < 2832)
              *(uint2*)(p.proj + (size_t)row * ld + col) = uint2{pack2(acc[i][j][0], acc[i][j][1]), pack2(acc[i][j][2], acc[i][j][3])};
          }
        }
      }
    } else if (EPI == EPI_OUT) {
#pragma unroll
      for (int i = 0; i < MI; ++i) {
        int row = rowbase + i * 16 + l15;
        const float* g1 = modp(p, layer, vec_of_row(row), 2);
        const float* xi = row < NLAT ? xin_lat + (size_t)row * 1024 : xin_ctx + (size_t)(row - NLAT) * 1024;
        float* xo = row < NLAT ? p.out + (size_t)row * 1024 : p.xc + (size_t)(row - NLAT) * 1024;
#pragma unroll
        for (int j = 0; j < 4; ++j) {
          int col = colbase + j * 16 + q * 4;
          f32x4 xv = *(const f32x4*)(xi + col), gv = *(const f32x4*)(g1 + col);
          f32x4 nv;
#pragma unroll
          for (int r = 0; r < 4; ++r) nv[r] = xv[r] + gv[r] * acc[i][j][r];
          if (!dry || nv[0] == -12345.678f) *(f32x4*)(xo + col) = nv;
        }
      }
    } else {
#pragma unroll
      for (int i = 0; i < MI; ++i) {
        int row = rowbase + i * 16 + l15;
#pragma unroll
        for (int j = 0; j < 4; ++j) {
          int col = colbase + j * 16 + q * 4;
          *(f32x4*)(p.pq + (size_t)row * 2048 + col) = acc[i][j];
        }
      }
    }
  }
}

template <int DV, int NC>
DI void flash_item(char* smem, const bf16_t* Qb, int ld, const bf16_t* Kc, const bf16_t* Vc, const bf16_t* Kl,
                   const bf16_t* Vl, int l_lo, int l_hi, int qpos0, int window, float sink, float scale,
                   f32x4 (&o)[NC][DV / 16], float (&m)[NC], float (&l)[NC]) {
  bf16_t* sK = (bf16_t*)smem;
  bf16_t* sVt = sK + NC * 64 * 80;
  const int tid0 = get_tid();
  const float L2E = 1.4426950408889634f;
  const float sc2 = scale * L2E;
  bf16x8 qf[NC][2];
  {
  const int lane = tid0 & 63, wave = tid0 >> 6, q = lane >> 4, l15 = lane & 15;
#pragma unroll
  for (int c = 0; c < NC; ++c)
#pragma unroll
    for (int ks = 0; ks < 2; ++ks)
      qf[c][ks] = *(const bf16x8*)(Qb + (size_t)(wave * 16 + l15) * ld + c * 64 + ks * 32 + q * 8);
  }
#pragma unroll
  for (int c = 0; c < NC; ++c) {
    m[c] = sink == -INFINITY ? -INFINITY : sink * L2E;
    l[c] = sink == -INFINITY ? 0.f : 1.f;
#pragma unroll
    for (int n = 0; n < DV / 16; ++n) o[c][n] = f32x4{0.f, 0.f, 0.f, 0.f};
  }
  const int nlt = l_hi > l_lo ? (l_hi - l_lo) / 64 : 0;
  const int ntiles = 4 + nlt;
  u32x4 kreg[NC][2], vreg[DV / 32];
  auto load_tile = [&](int it2) {
    const int tidl = tid0;
    const bf16_t *Kr2, *Vr2;
    if (it2 < 4) {
      Kr2 = Kc + (size_t)(it2 * 64) * ld;
      Vr2 = Vc + (size_t)(it2 * 64) * ld;
    } else {
      int kp = l_lo + (it2 - 4) * 64;
      Kr2 = Kl + (size_t)kp * ld;
      Vr2 = Vl + (size_t)kp * ld;
    }
    int key = tidl >> 2, part = tidl & 3;
#pragma unroll
    for (int c = 0; c < NC; ++c) {
      const bf16_t* sp = Kr2 + (size_t)key * ld + c * 64 + part * 16;
      kreg[c][0] = *(const u32x4*)sp;
      kreg[c][1] = *(const u32x4*)(sp + 8);
    }
    int vkey = tidl & 63, cg4 = tidl >> 6;
#pragma unroll
    for (int i = 0; i < DV / 32; ++i) vreg[i] = *(const u32x4*)(Vr2 + (size_t)vkey * ld + (cg4 + 4 * i) * 8);
  };
  load_tile(0);
  for (int it = 0; it < ntiles; ++it) {
    int tid = tid0;
    asm volatile("" : "+v"(tid));
    const int lane = tid & 63, wave = tid >> 6, q = lane >> 4, l15 = lane & 15;
    const int kpos0 = it < 4 ? -(1 << 28) : l_lo + (it - 4) * 64;
    __syncthreads();
    {
      int key = tid >> 2, part = tid & 3;
#pragma unroll
      for (int c = 0; c < NC; ++c) {
        *(u32x4*)(sK + (c * 64 + key) * 80 + part * 16) = kreg[c][0];
        *(u32x4*)(sK + (c * 64 + key) * 80 + part * 16 + 8) = kreg[c][1];
      }
      int vkey = tid & 63, cg4 = tid >> 6;
#pragma unroll
      for (int i = 0; i < DV / 32; ++i) {
        int e0 = (cg4 + 4 * i) * 8;
#pragma unroll
        for (int j = 0; j < 4; ++j) {
          sVt[(e0 + 2 * j) * 72 + vkey] = (bf16_t)(vreg[i][j] & 0xffffu);
          sVt[(e0 + 2 * j + 1) * 72 + vkey] = (bf16_t)(vreg[i][j] >> 16);
        }
      }
    }
    __syncthreads();
    if (it + 1 < ntiles) load_tile(it + 1);
    bf16x8 pf[NC][2];
#pragma unroll
    for (int c = 0; c < NC; ++c) {
      f32x4 s[4];
#pragma unroll
      for (int nt = 0; nt < 4; ++nt) {
        s[nt] = f32x4{0.f, 0.f, 0.f, 0.f};
#pragma unroll
        for (int ks = 0; ks < 2; ++ks)
          s[nt] = mfma16(ldfrag(sK + (c * 64 + nt * 16 + l15) * 80 + ks * 32 + q * 8), qf[c][ks], s[nt]);
      }
      float mx = -INFINITY;
      if (NC == 1 && kpos0 >= 0) {
#pragma unroll
        for (int nt = 0; nt < 4; ++nt)
#pragma unroll
          for (int r = 0; r < 4; ++r) {
            int d = (kpos0 + nt * 16 + q * 4 + r) - (qpos0 + wave * 16 + l15);
            if (d > window || d < -window) s[nt][r] = -INFINITY;
          }
      }
#pragma unroll
      for (int nt = 0; nt < 4; ++nt)
#pragma unroll
        for (int r = 0; r < 4; ++r) mx = fmaxf(mx, s[nt][r]);
      mx = rows_max(mx) * sc2;
      const float mn = fmaxf(m[c], mx);
      const float alpha = __builtin_amdgcn_exp2f(m[c] - mn);
      float rs = 0.f;
#pragma unroll
      for (int nt = 0; nt < 4; ++nt)
#pragma unroll
        for (int r = 0; r < 4; ++r) {
          float pv = __builtin_amdgcn_exp2f(__builtin_fmaf(s[nt][r], sc2, -mn));
          s[nt][r] = pv;
          rs += pv;
        }
      rs = rows_sum(rs);
      l[c] = l[c] * alpha + rs;
      m[c] = mn;
#pragma unroll
      for (int n = 0; n < DV / 16; ++n)
#pragma unroll
        for (int r = 0; r < 4; ++r) o[c][n][r] *= alpha;
      pf[c][0] = packfrag(s[0], s[1]);
      pf[c][1] = packfrag(s[2], s[3]);
    }
#pragma unroll
    for (int ks = 0; ks < 2; ++ks) {
#pragma unroll
      for (int n = 0; n < DV / 16; ++n) {
        bf16x8 vf = ldfrag_perm(sVt + (n * 16 + l15) * 72, ks, q);
#pragma unroll
        for (int c = 0; c < NC; ++c) o[c][n] = mfma16(vf, pf[c][ks], o[c][n]);
      }
    }
  }
}

DI void diff_item(const Params& p, char* smem, int b, int h, int qb, bool is_ctx, float lam) {
  const int lane = get_tid() & 63, wave = get_tid() >> 6, q = lane >> 4, l15 = lane & 15;
  const int ctxrow0 = NLAT + b * LL;
  const int qrow0 = is_ctx ? ctxrow0 + qb * 64 : b * TT + qb * 64;
  const bf16_t* Qb = p.proj + (size_t)qrow0 * LD0 + h * 128;
  const bf16_t* Kc = p.proj + (size_t)ctxrow0 * LD0 + 512 + h * 128;
  const bf16_t* Vc = p.proj + (size_t)ctxrow0 * LD0 + 1024 + h * 128;
  const bf16_t* Kl = p.proj + (size_t)(b * TT) * LD0 + 512 + h * 128;
  const bf16_t* Vl = p.proj + (size_t)(b * TT) * LD0 + 1024 + h * 128;
  f32x4 o[2][8];
  float m[2], l[2];
  flash_item<128, 2>(smem, Qb, LD0, Kc, Vc, Kl, Vl, 0, is_ctx ? 0 : TT, 0, -1, -INFINITY, 0.125f, o, m, l);
  const float* sw = p.diff_subln_w;
  const float i0 = 1.f / l[0], i1 = lam / l[1];
  float ss = 0.f;
#pragma unroll
  for (int n = 0; n < 8; ++n)
#pragma unroll
    for (int r = 0; r < 4; ++r) {
      float v = o[0][n][r] * i0 - o[1][n][r] * i1;
      o[0][n][r] = v;
      ss += v * v;
    }
  ss = rows_sum(ss);
  const float rstd = rsqrtf(ss * (1.f / 128.f) + 1e-6f) * 0.8f;
  const int row = qrow0 + wave * 16 + l15;
#pragma unroll
  for (int n = 0; n < 8; ++n) {
    f32x4 w4 = *(const f32x4*)(sw + n * 16 + q * 4);
    uint2 ov;
    ov.x = pack2(o[0][n][0] * rstd * w4[0], o[0][n][1] * rstd * w4[1]);
    ov.y = pack2(o[0][n][2] * rstd * w4[2], o[0][n][3] * rstd * w4[3]);
    *(uint2*)(p.mix + (size_t)row * 1024 + h * 128 + n * 16 + q * 4) = ov;
  }
}

DI void swa_item(const Params& p, char* smem, int b, int h, int qb) {
  const int lane = get_tid() & 63, wave = get_tid() >> 6, q = lane >> 4, l15 = lane & 15;
  const int kvh = h >> 2;
  const int ctxrow0 = NLAT + b * LL;
  const int qrow0 = b * TT + qb * 64;
  const bf16_t* Qb = p.proj + (size_t)qrow0 * LD1 + 2048 + h * 64;
  const bf16_t* Kc = p.proj + (size_t)ctxrow0 * LD1 + 2560 + kvh * 64;
  const bf16_t* Vc = p.proj + (size_t)ctxrow0 * LD1 + 2688 + kvh * 64;
  const bf16_t* Kl = p.proj + (size_t)(b * TT) * LD1 + 2560 + kvh * 64;
  const bf16_t* Vl = p.proj + (size_t)(b * TT) * LD1 + 2688 + kvh * 64;
  int lo = qb * 64 - 128, hi = qb * 64 + 64 + 128;
  if (lo < 0) lo = 0;
  if (hi > TT) hi = TT;
  f32x4 o[1][4];
  float m[1], l[1];
  flash_item<64, 1>(smem, Qb, LD1, Kc, Vc, Kl, Vl, lo, hi, qb * 64, 128, p.swa_sink[h], 0.125f, o, m, l);
  const float inv = 1.f / l[0];
  const int row = qrow0 + wave * 16 + l15;
#pragma unroll
  for (int n = 0; n < 4; ++n) {
    uint2 ov;
    ov.x = pack2(o[0][n][0] * inv, o[0][n][1] * inv);
    ov.y = pack2(o[0][n][2] * inv, o[0][n][3] * inv);
    *(uint2*)(p.mix + (size_t)row * 1024 + 512 + h * 64 + n * 16 + q * 4) = ov;
  }
}

DI void hgrn_item(const Params& p, char* smem, int b, int head) {
  bf16_t* sQt = (bf16_t*)smem;
  bf16_t* sKt = sQt + 32 * 72;
  bf16_t* sQS = sKt + 32 * 72;
  bf16_t* sKST = sQS + 32 * 72;
  bf16_t* sVT = sKST + 64 * 40;
  bf16_t* sAtt = sVT + 64 * 40;
  bf16_t* sST = sAtt + 32 * 40;
  float* sO = (float*)(sST + 64 * 72);
  float* sGs = sO + 32 * 65;
  float* sG16 = sGs + 256;
  float* sEB = sG16 + 64;
  const int tid0 = get_tid();
  const int ch = head * 64 + (tid0 & 63);
  float lb;
  {
    float a0 = p.hgrn_lb[ch], a1 = p.hgrn_lb[512 + ch], a2 = p.hgrn_lb[1024 + ch];
    float mx = fmaxf(a0, fmaxf(a1, a2));
    float e0 = expf(a0 - mx), e1 = expf(a1 - mx), e2 = expf(a2 - mx);
    lb = e0 / (e0 + e1 + e2);
  }
  for (int dir = 0; dir < 2; ++dir) {
    const bool rev = dir == 1;
    f32x4 S[4];
    bf16_t nq[8], ni[8], nf[8];
#pragma unroll
    for (int n = 0; n < 4; ++n) S[n] = f32x4{0.f, 0.f, 0.f, 0.f};
    __syncthreads();
    for (int i = tid0; i < 64 * 72; i += NTHREADS) sST[i] = 0;
    for (int step = 0; step < 72; ++step) {
      int tid = tid0;
      asm volatile("" : "+v"(tid));
      const int lane = tid & 63, wave = tid >> 6, q = lane >> 4, l15 = lane & 15;
      const int c = tid & 63, tg = tid >> 6;
      const bool isctx = step < 8;
      const int n = isctx ? LL : TT;
      const int j = isctx ? step : step - 8;
      const int rowseg = isctx ? NLAT + b * LL : b * TT;
      float qv[8], kk[8], vv[8], cs[8];
      float run = 0.f;
      if (step == 0) {
#pragma unroll
        for (int jj = 0; jj < 8; ++jj) {
          int pp = tg * 8 + jj;
          int tok = rev ? n - 1 - (32 * j + pp) : 32 * j + pp;
          const bf16_t* pr = p.proj + (size_t)(rowseg + tok) * LD0;
          nq[jj] = pr[1536 + ch];
          ni[jj] = pr[2048 + ch];
          nf[jj] = pr[(rev ? 3072 : 2560) + ch];
        }
      }
#pragma unroll
      for (int jj = 0; jj < 8; ++jj) {
        float qr = bf2f(nq[jj]), ir = bf2f(ni[jj]), fl = bf2f(nf[jj]);
        qv[jj] = silu_fast(qr) * 0.125f;
        float f = lb + (1.f - lb) * __fdividef(1.f, 1.f + __expf(-fl));
        kk[jj] = 1.f - f;
        vv[jj] = ir;
        run += __logf(f);
        cs[jj] = run;
      }
      if (step + 1 < 72) {
        const int s2 = step + 1;
        const bool isctx2 = s2 < 8;
        const int n2 = isctx2 ? LL : TT;
        const int j2 = isctx2 ? s2 : s2 - 8;
        const int rowseg2 = isctx2 ? NLAT + b * LL : b * TT;
#pragma unroll
        for (int jj = 0; jj < 8; ++jj) {
          int pp = tg * 8 + jj;
          int tok = rev ? n2 - 1 - (32 * j2 + pp) : 32 * j2 + pp;
          const bf16_t* pr = p.proj + (size_t)(rowseg2 + tok) * LD0;
          nq[jj] = pr[1536 + ch];
          ni[jj] = pr[2048 + ch];
          nf[jj] = pr[(rev ? 3072 : 2560) + ch];
        }
      }
      sGs[tg * 64 + c] = run;
      if (tg == 2) sG16[c] = cs[0];
      __syncthreads();
      {
        float g0 = sGs[c], g1 = sGs[64 + c], g2 = sGs[128 + c], g3 = sGs[192 + c];
        float off = tg == 0 ? 0.f : (tg == 1 ? g0 : (tg == 2 ? g0 + g1 : g0 + g1 + g2));
        float blast = g0 + g1 + g2 + g3;
        float ref = g0 + g1 + sG16[c];
#pragma unroll
        for (int jj = 0; jj < 8; ++jj) {
          int pp = tg * 8 + jj;
          float bj = off + cs[jj];
          sQt[pp * 72 + c] = f2bf(qv[jj] * __expf(bj - ref));
          sKt[pp * 72 + c] = f2bf(kk[jj] * __expf(ref - bj));
          sQS[pp * 72 + c] = f2bf(qv[jj] * __expf(bj));
          sKST[c * 40 + pp] = f2bf(kk[jj] * __expf(blast - bj));
          sVT[c * 40 + pp] = f2bf(vv[jj]);
        }
        if (tg == 0) sEB[c] = __expf(blast);
      }
      __syncthreads();
      {
        const int mt = wave & 1, nt0 = (wave >> 1) * 2;
        f32x4 aT[2];
#pragma unroll
        for (int kt = 0; kt < 2; ++kt) {
          aT[kt] = f32x4{0.f, 0.f, 0.f, 0.f};
#pragma unroll
          for (int ks = 0; ks < 2; ++ks)
            aT[kt] = mfma16(ldfrag(sKt + (kt * 16 + l15) * 72 + ks * 32 + q * 8),
                            ldfrag(sQt + (mt * 16 + l15) * 72 + ks * 32 + q * 8), aT[kt]);
#pragma unroll
          for (int r = 0; r < 4; ++r) {
            int ki = kt * 16 + q * 4 + r, qi = mt * 16 + l15;
            if (ki > qi) aT[kt][r] = 0.f;
          }
        }
        const bf16x8 attf = packfrag(aT[0], aT[1]);
        const bf16x8 q0 = ldfrag(sQS + (mt * 16 + l15) * 72 + q * 8), q1 = ldfrag(sQS + (mt * 16 + l15) * 72 + 32 + q * 8);
#pragma unroll
        for (int t2 = 0; t2 < 2; ++t2) {
          int nt = nt0 + t2;
          f32x4 a = f32x4{0.f, 0.f, 0.f, 0.f};
          a = mfma16(ldfrag_perm(sVT + (nt * 16 + l15) * 40, 0, q), attf, a);
          a = mfma16(ldfrag(sST + (nt * 16 + l15) * 72 + q * 8), q0, a);
          a = mfma16(ldfrag(sST + (nt * 16 + l15) * 72 + 32 + q * 8), q1, a);
#pragma unroll
          for (int r = 0; r < 4; ++r) sO[(mt * 16 + l15) * 65 + nt * 16 + q * 4 + r] = a[r];
        }
      }
      __syncthreads();
      {
        bf16x8 af = ldfrag(sKST + (wave * 16 + l15) * 40 + q * 8);
        float eb[4];
#pragma unroll
        for (int r = 0; r < 4; ++r) eb[r] = sEB[wave * 16 + q * 4 + r];
#pragma unroll
        for (int nt = 0; nt < 4; ++nt) {
#pragma unroll
          for (int r = 0; r < 4; ++r) S[nt][r] *= eb[r];
          S[nt] = mfma16(af, ldfrag(sVT + (nt * 16 + l15) * 40 + q * 8), S[nt]);
          uint2 w;
          w.x = pack2(S[nt][0], S[nt][1]);
          w.y = pack2(S[nt][2], S[nt][3]);
          *(uint2*)(sST + (nt * 16 + l15) * 72 + wave * 16 + q * 4) = w;
        }
        int pp = tid >> 3, eg = tid & 7;
        int tok = rev ? n - 1 - (32 * j + pp) : 32 * j + pp;
        size_t row = (size_t)(rowseg + tok);
        bf16_t* dst = p.mix + row * 1024 + 512 + head * 64 + eg * 8;
        float val[8];
#pragma unroll
        for (int k = 0; k < 8; ++k) val[k] = sO[pp * 65 + eg * 8 + k];
        if (!rev) {
          uint4 w;
          w.x = pack2(val[0], val[1]);
          w.y = pack2(val[2], val[3]);
          w.z = pack2(val[4], val[5]);
          w.w = pack2(val[6], val[7]);
          *(uint4*)dst = w;
        } else {
          uint4 of = *(const uint4*)dst;
          unsigned ow[4] = {of.x, of.y, of.z, of.w};
          float ss = 0.f;
#pragma unroll
          for (int k = 0; k < 4; ++k) {
            val[2 * k] += __uint_as_float(ow[k] << 16);
            val[2 * k + 1] += __uint_as_float(ow[k] & 0xffff0000u);
          }
#pragma unroll
          for (int k = 0; k < 8; ++k) ss += val[k] * val[k];
          ss += __shfl_xor(ss, 1);
          ss += __shfl_xor(ss, 2);
          ss += __shfl_xor(ss, 4);
          float rstd = rsqrtf(ss * (1.f / 64.f) + 1e-6f);
          uint4 gq = *(const uint4*)(p.proj + row * LD0 + 3584 + head * 64 + eg * 8);
          unsigned gw[4] = {gq.x, gq.y, gq.z, gq.w};
          float outv[8];
#pragma unroll
          for (int k = 0; k < 4; ++k) {
            float ga = __uint_as_float(gw[k] << 16), gb = __uint_as_float(gw[k] & 0xffff0000u);
            outv[2 * k] = val[2 * k] * rstd * p.hgrn_norm_w[eg * 8 + 2 * k] * silu_fast(ga);
            outv[2 * k + 1] = val[2 * k + 1] * rstd * p.hgrn_norm_w[eg * 8 + 2 * k + 1] * silu_fast(gb);
          }
          uint4 w;
          w.x = pack2(outv[0], outv[1]);
          w.y = pack2(outv[2], outv[3]);
          w.z = pack2(outv[4], outv[5]);
          w.w = pack2(outv[6], outv[7]);
          *(uint4*)dst = w;
        }
      }
    }
  }
}

DI void gdn_item(const Params& p, char* smem, int b, int head, int dir, int ehalf) {
  bf16_t* sQ = (bf16_t*)smem;
  bf16_t* sK = sQ + 64 * 136;
  bf16_t* sW = sK + 64 * 136;
  bf16_t* sV = sW + 64 * 136;
  float* sA = (float*)(sV + 64 * 72);
  float* sG = sA + 64 * 64;
  float* sBeta = sG + 64;
  float* sRq = sBeta + 64;
  float* sRk = sRq + 64;
  float* sEg = sRk + 64;
  bf16_t* sKdT = sW;
  bf16_t* sAtt = (bf16_t*)sA;
  const int tid0 = get_tid();
  const bool rev = dir == 1;
  const float neg_a = -expf(p.gdn_a_log[dir * 4 + head]);
  const float dtb = p.gdn_dt_bias[dir * 4 + head];
  bf16_t* gout = (dir == 0 ? p.gdn_of : p.gdn_ob);
  f32x4 S[8];
#pragma unroll
  for (int i = 0; i < 8; ++i) S[i] = f32x4{0.f, 0.f, 0.f, 0.f};
  for (int step = 0; step < 36; ++step) {
    int tid = tid0;
    asm volatile("" : "+v"(tid));
    const int lane = tid & 63, wave = tid >> 6, q = lane >> 4, l15 = lane & 15;
    const bool isctx = step < 4;
    const int n = isctx ? LL : TT;
    const int j = isctx ? step : step - 4;
    const int rowseg = isctx ? NLAT + b * LL : b * TT;
    const int lo = rev ? n - 64 * (j + 1) : 64 * j;
    __syncthreads();
    {
      bf16_t* rawA = sW;
      bf16_t* rawV = (bf16_t*)sA;
      const bf16_t* gbase = p.proj + (size_t)rowseg * LD1;
      const u32x4 zz = u32x4{0u, 0u, 0u, 0u};
      u32x4 rq[5], rk[5], rv[3];
#pragma unroll
      for (int i = 0; i < 5; ++i) {
        int chn = tid + 256 * i;
        int row = chn >> 4, part = chn & 15;
        int t = lo - 2 + row;
        bool ok = chn < 1088 && t >= 0 && t < n;
        const bf16_t* gp = gbase + (size_t)(ok ? t : 0) * LD1 + head * 128 + part * 8;
        rq[i] = ok ? *(const u32x4*)gp : zz;
        rk[i] = ok ? *(const u32x4*)(gp + 512) : zz;
      }
#pragma unroll
      for (int i = 0; i < 3; ++i) {
        int chn = tid + 256 * i;
        int row = chn >> 3, part = chn & 7;
        int t = lo - 2 + row;
        bool ok = chn < 544 && t >= 0 && t < n;
        const bf16_t* gp = gbase + (size_t)(ok ? t : 0) * LD1 + 1024 + head * 128 + ehalf * 64 + part * 8;
        rv[i] = ok ? *(const u32x4*)gp : zz;
      }
#pragma unroll
      for (int i = 0; i < 5; ++i) {
        int chn = tid + 256 * i;
        if (chn < 1088) *(u32x4*)(rawA + chn * 8) = rq[i];
      }
#pragma unroll
      for (int i = 0; i < 3; ++i) {
        int chn = tid + 256 * i;
        if (chn < 544) *(u32x4*)(rawV + chn * 8) = rv[i];
      }
      __syncthreads();
      const int c = tid & 127, th = tid >> 7;
      auto conv_from = [&](const bf16_t* raw, int stride, int col, bf16_t* dst, int dstride) {
        float w0 = p.gdn_conv_w[col], w1 = p.gdn_conv_w[1536 + col], w2 = p.gdn_conv_w[2 * 1536 + col],
              w3 = p.gdn_conv_w[3 * 1536 + col], w4 = p.gdn_conv_w[4 * 1536 + col];
        const bf16_t* rp = raw + (th * 32) * stride + c;
        float x0 = bf2f(rp[0]), x1 = bf2f(rp[stride]), x2 = bf2f(rp[2 * stride]), x3 = bf2f(rp[3 * stride]);
#pragma unroll
        for (int tt = 0; tt < 32; ++tt) {
          float x4 = bf2f(rp[(tt + 4) * stride]);
          float y = w0 * x0 + w1 * x1 + w2 * x2 + w3 * x3 + w4 * x4;
          y = silu_fast(y);
          int tl = th * 32 + tt;
          int pp = rev ? 63 - tl : tl;
          dst[pp * dstride + c] = f2bf(y);
          x0 = x1; x1 = x2; x2 = x3; x3 = x4;
        }
      };
      conv_from(rawA, 128, head * 128 + c, sQ, 136);
      if (c < 64) conv_from(rawV, 64, 1024 + head * 128 + ehalf * 64 + c, sV, 72);
      __syncthreads();
#pragma unroll
      for (int i = 0; i < 5; ++i) {
        int chn = tid + 256 * i;
        if (chn < 1088) *(u32x4*)(rawA + chn * 8) = rk[i];
      }
      __syncthreads();
      conv_from(rawA, 128, 512 + head * 128 + c, sK, 136);
      if (tid < 64) {
        int pp = tid;
        int tok = rev ? n - 1 - (64 * j + pp) : 64 * j + pp;
        const bf16_t* pr = p.proj + (size_t)(rowseg + tok) * LD1 + 2816;
        float a = bf2f(pr[dir * 4 + head]), bt = bf2f(pr[8 + dir * 4 + head]);
        float xs = a + dtb;
        float sp = xs > 20.f ? xs : log1pf(expf(xs));
        float g = neg_a * sp;
#pragma unroll
        for (int o = 1; o < 64; o <<= 1) {
          float t = __shfl_up(g, o);
          if (lane >= o) g += t;
        }
        sG[pp] = g;
        sEg[pp] = expf(g);
        sBeta[pp] = sigmoidf_(bt);
      }
    }
    __syncthreads();
    {
      int pp = tid >> 2, part = tid & 3;
      float sq = 0.f, sk = 0.f;
#pragma unroll 8
      for (int k = 0; k < 32; ++k) {
        float a = bf2f(sQ[pp * 136 + part * 32 + k]), bb = bf2f(sK[pp * 136 + part * 32 + k]);
        sq += a * a;
        sk += bb * bb;
      }
      sq += __shfl_xor(sq, 1); sq += __shfl_xor(sq, 2);
      sk += __shfl_xor(sk, 1); sk += __shfl_xor(sk, 2);
      if (part == 0) {
        sRq[pp] = rsqrtf(sq + 1e-6f) * 0.08838834764831845f;
        sRk[pp] = rsqrtf(sk + 1e-6f);
      }
    }
    __syncthreads();
    {
      const int mt = wave;
#pragma unroll
      for (int nt = 0; nt < 4; ++nt) {
        f32x4 a = f32x4{0.f, 0.f, 0.f, 0.f};
        if (nt <= mt) {
#pragma unroll
          for (int ks = 0; ks < 4; ++ks)
            a = mfma16(ldfrag(sK + (mt * 16 + l15) * 136 + ks * 32 + q * 8),
                       ldfrag(sK + (nt * 16 + l15) * 136 + ks * 32 + q * 8), a);
        }
        int jj = nt * 16 + l15;
        float rkj = sRk[jj], gj = sG[jj];
        f32x4 av;
#pragma unroll
        for (int r = 0; r < 4; ++r) {
          int ii = mt * 16 + q * 4 + r;
          float v = 0.f;
          if (ii > jj) v = a[r] * sRk[ii] * rkj * sBeta[ii] * __expf(sG[ii] - gj);
          av[r] = v;
        }
        *(f32x4*)(sA + jj * 64 + mt * 16 + q * 4) = av;
      }
    }
    __syncthreads();
    {
      auto solve = [&](auto UP, int cidx) {
        constexpr bool upart = decltype(UP)::value;
        bf16_t* dstb = upart ? sV + cidx : sW + cidx;
        const bf16_t* srcb = upart ? sV + cidx : sK + cidx;
        constexpr int dstr = upart ? 72 : 136;
#pragma unroll 1
        for (int bi = 0; bi < 4; ++bi) {
          float acc[16];
#pragma unroll
          for (int r = 0; r < 16; ++r) {
            int i = bi * 16 + r;
            float rv = bf2f(srcb[i * dstr]) * sBeta[i];
            if (!upart) rv *= sRk[i] * sEg[i];
            acc[r] = rv;
          }
#pragma unroll 8
          for (int j = 0; j < bi * 16; ++j) {
            float sj = bf2f(dstb[j * dstr]);
            const f32x4* ap = (const f32x4*)(sA + j * 64 + bi * 16);
            f32x4 a0 = ap[0], a1 = ap[1], a2 = ap[2], a3 = ap[3];
#pragma unroll
            for (int k = 0; k < 4; ++k) {
              acc[k] -= a0[k] * sj;
              acc[4 + k] -= a1[k] * sj;
              acc[8 + k] -= a2[k] * sj;
              acc[12 + k] -= a3[k] * sj;
            }
          }
          const float* ab = sA + (bi * 16) * 64 + bi * 16;
#pragma unroll
          for (int r = 0; r < 16; ++r) {
            float sr = acc[r];
            dstb[(bi * 16 + r) * dstr] = f2bf(sr);
#pragma unroll
            for (int r2 = r + 1; r2 < 16; ++r2) acc[r2] -= ab[r * 64 + r2] * sr;
            if ((r & 7) == 7) __builtin_amdgcn_sched_barrier(0);
          }
        }
      };
      if (tid < 64) solve(std::true_type{}, tid);
      else if (tid < 192) solve(std::false_type{}, tid - 64);
    }
    __syncthreads();
    f32x4 vn[4], oo[4];
    {
      bf16x8 sf[4];
#pragma unroll
      for (int ks = 0; ks < 4; ++ks) sf[ks] = packfrag(S[2 * ks], S[2 * ks + 1]);
#pragma unroll
      for (int mt = 0; mt < 4; ++mt) {
        f32x4 ws = f32x4{0.f, 0.f, 0.f, 0.f}, qs = f32x4{0.f, 0.f, 0.f, 0.f};
#pragma unroll
        for (int ks = 0; ks < 4; ++ks) {
          ws = mfma16(ldfrag_perm(sW + (mt * 16 + l15) * 136, ks, q), sf[ks], ws);
          qs = mfma16(ldfrag_perm(sQ + (mt * 16 + l15) * 136, ks, q), sf[ks], qs);
        }
#pragma unroll
        for (int r = 0; r < 4; ++r) {
          int ii = mt * 16 + q * 4 + r;
          vn[mt][r] = bf2f(sV[ii * 72 + wave * 16 + l15]) - ws[r];
          oo[mt][r] = qs[r] * sRq[ii] * sEg[ii];
        }
        asm volatile("" : "+v"(vn[mt]), "+v"(oo[mt]));
      }
    }
    __syncthreads();
    {
      const int d = tid & 127, hf = tid >> 7;
      const float glast = sG[63];
#pragma unroll 4
      for (int jj = 0; jj < 32; ++jj) {
        int jt = hf * 32 + jj;
        sKdT[d * 68 + jt] = f2bf(bf2f(sK[jt * 136 + d]) * sRk[jt] * __expf(glast - sG[jt]));
      }
      const int mt = wave;
      f32x4 a[4];
#pragma unroll
      for (int nt = 0; nt < 4; ++nt) {
        a[nt] = f32x4{0.f, 0.f, 0.f, 0.f};
        if (nt <= mt) {
#pragma unroll
          for (int ks = 0; ks < 4; ++ks)
            a[nt] = mfma16(ldfrag(sQ + (mt * 16 + l15) * 136 + ks * 32 + q * 8),
                           ldfrag(sK + (nt * 16 + l15) * 136 + ks * 32 + q * 8), a[nt]);
        }
      }
#pragma unroll
      for (int nt = 0; nt < 4; ++nt) {
        int jj = nt * 16 + l15;
        float rkj = sRk[jj], gj = sG[jj];
#pragma unroll
        for (int r = 0; r < 4; ++r) {
          int ii = mt * 16 + q * 4 + r;
          float v = 0.f;
          if (ii >= jj) v = a[nt][r] * sRq[ii] * rkj * __expf(sG[ii] - gj);
          sAtt[ii * 72 + jj] = f2bf(v);
        }
      }
    }
    __syncthreads();
    {
      bf16x8 vf[2];
      vf[0] = packfrag(vn[0], vn[1]);
      vf[1] = packfrag(vn[2], vn[3]);
#pragma unroll
      for (int mt = 0; mt < 4; ++mt)
#pragma unroll
        for (int ks = 0; ks < 2; ++ks) oo[mt] = mfma16(ldfrag_perm(sAtt + (mt * 16 + l15) * 72, ks, q), vf[ks], oo[mt]);
      __builtin_amdgcn_sched_barrier(0);
      if (!isctx) {
        bf16_t* gb = gout + (size_t)(b * TT) * 512 + head * 128 + ehalf * 64;
        const int tok0 = rev ? n - 1 - (64 * j + q * 4) : 64 * j + q * 4;
        const int tstep = rev ? -512 : 512;
        unsigned off0 = (unsigned)(tok0 * 512 + wave * 16 + l15);
#pragma unroll
        for (int mt = 0; mt < 4; ++mt)
#pragma unroll
          for (int r = 0; r < 4; ++r) {
            unsigned off = off0 + (unsigned)((mt * 16 + r) * tstep);
            gb[off] = f2bf(oo[mt][r]);
          }
      }
      __builtin_amdgcn_sched_barrier(0);
      const float egl = sEg[63];
#pragma unroll
      for (int m8 = 0; m8 < 8; ++m8) {
#pragma unroll
        for (int r = 0; r < 4; ++r) S[m8][r] *= egl;
#pragma unroll
        for (int ks = 0; ks < 2; ++ks) S[m8] = mfma16(ldfrag_perm(sKdT + (m8 * 16 + l15) * 68, ks, q), vf[ks], S[m8]);
        __builtin_amdgcn_sched_barrier(0);
      }
    }
  }
}

DI void phase_gdn_finalize(const Params& p) {
  const int tid = get_tid();
  const int gid = blockIdx.x * NTHREADS + tid;
  const int nth = gridDim.x * NTHREADS;
  const int l32 = tid & 31;
  for (int w = gid >> 5; w < NLAT * 4; w += nth >> 5) {
    int tok = w >> 2, head = w & 3;
    size_t off = (size_t)tok * 512 + head * 128 + l32 * 4;
    uint2 a = *(const uint2*)(p.gdn_of + off), bq = *(const uint2*)(p.gdn_ob + off);
    float v[4];
    v[0] = __uint_as_float(a.x << 16) + __uint_as_float(bq.x << 16);
    v[1] = __uint_as_float(a.x & 0xffff0000u) + __uint_as_float(bq.x & 0xffff0000u);
    v[2] = __uint_as_float(a.y << 16) + __uint_as_float(bq.y << 16);
    v[3] = __uint_as_float(a.y & 0xffff0000u) + __uint_as_float(bq.y & 0xffff0000u);
    float ss = v[0] * v[0] + v[1] * v[1] + v[2] * v[2] + v[3] * v[3];
#pragma unroll
    for (int o = 16; o >= 1; o >>= 1) ss += __shfl_xor(ss, o);
    float rstd = rsqrtf(ss * (1.f / 128.f) + 1e-6f);
    uint2 zq = *(const uint2*)(p.proj + (size_t)tok * LD1 + 1536 + head * 128 + l32 * 4);
    float z[4] = {__uint_as_float(zq.x << 16), __uint_as_float(zq.x & 0xffff0000u), __uint_as_float(zq.y << 16),
                  __uint_as_float(zq.y & 0xffff0000u)};
    float4 nw = *(const float4*)(p.gdn_norm_w + l32 * 4);
    uint2 o;
    o.x = pack2(v[0] * rstd * nw.x * siluf(z[0]), v[1] * rstd * nw.y * siluf(z[1]));
    o.y = pack2(v[2] * rstd * nw.z * siluf(z[2]), v[3] * rstd * nw.w * siluf(z[3]));
    *(uint2*)(p.mix + (size_t)tok * 1024 + head * 128 + l32 * 4) = o;
  }
}

DI int next_item(unsigned* counter, int* sslot) {
  __syncthreads();
  if (get_tid() == 0) *sslot = (int)atomicAdd(counter, 1u);
  __syncthreads();
  return *sslot;
}

DI void phase_mixer0(const Params& p, char* smem, int rep) {
  int* sslot = (int*)(smem + SMEM_BYTES - 16);
  float lam;
  {
    float s1 = 0.f, s2 = 0.f;
    for (int i = 0; i < 64; ++i) {
      s1 += p.diff_lambda[i] * p.diff_lambda[64 + i];
      s2 += p.diff_lambda[128 + i] * p.diff_lambda[192 + i];
    }
    lam = expf(s1) - expf(s2) + 0.2f;
  }
  const int NH = 256, NDL = NB * 4 * 32, NDC = NB * 4 * 4;
  while (true) {
    int item = next_item(p.counters + 0 + 2 * rep, sslot);
    if (item >= NH + NDL + NDC) break;
    if (item < NH) {
      hgrn_item(p, smem, item >> 3, item & 7);
    } else if (item < NH + NDL) {
      int i = item - NH;
      diff_item(p, smem, i >> 7, (i >> 5) & 3, i & 31, false, lam);
    } else {
      int i = item - NH - NDL;
      diff_item(p, smem, i >> 4, (i >> 2) & 3, i & 3, true, lam);
    }
  }
}

DI void phase_mixer1(const Params& p, char* smem, int rep) {
  int* sslot = (int*)(smem + SMEM_BYTES - 16);
  const int NG = 512, NS = NB * 8 * 32;
  while (true) {
    int item = next_item(p.counters + 1 + 2 * rep, sslot);
    if (item >= NG + NS) break;
    if (item < NG) {
      gdn_item(p, smem, item >> 4, (item >> 2) & 3, (item >> 1) & 1, item & 1);
    } else {
      int i = item - NG;
      swa_item(p, smem, i >> 8, (i >> 5) & 7, i & 31);
    }
  }
}

DI int quad_sum_i(int c) { return rows_sum_i(c); }
DI float quad_max_f(float v) { return rows_max(v); }
DI float quad_min_f(float v) { return rows_min(v); }
template <int NV>
DI float bisect16(const float (&v)[NV], float lo, float hi) {
  bool done = false;
  float tau = hi;
  for (int it = 0; it < 48; ++it) {
    float mid = 0.5f * (lo + hi);
    int c = 0;
#pragma unroll
    for (int k = 0; k < NV; ++k) c += (v[k] > mid) ? 1 : 0;
    c = quad_sum_i(c);
    if (!done) {
      if (c == 16) {
        done = true;
        tau = mid;
      } else if (c > 16) lo = mid;
      else hi = mid;
      if (!done) tau = hi;
    }
    if (__ballot(!done) == 0ull) break;
  }
  return tau;
}

DI void phase_topk(const Params& p, char* smem, int layer, int ntok) {
  const int tid0 = get_tid();
  const int nunits = (ntok / 16) * 2;
  for (int unit = blockIdx.x * 4 + (tid0 >> 6); unit < nunits; unit += gridDim.x * 4) {
    const int tok0 = (unit >> 1) * 16, hh = unit & 1;
    for (int h = hh * 4; h < hh * 4 + 4; ++h) {
      int tid = tid0;
      asm volatile("" : "+v"(tid));
      const int lane = tid & 63, wave = tid >> 6, q = lane >> 4, l15 = lane & 15;
      float* selV = (float*)smem + wave * 1536;
      int* selI = (int*)(selV + 512);
      float* outV = selV + 1024;
      int* outI = (int*)(selV + 1280);
      {
        f32x4 ninf = f32x4{-INFINITY, -INFINITY, -INFINITY, -INFINITY};
        u32x4 z = u32x4{0u, 0u, 0u, 0u};
        *(f32x4*)(selV + (l15 * 16) + q * 4) = ninf;
        *(f32x4*)(selV + 256 + (l15 * 16) + q * 4) = ninf;
        *(u32x4*)(selI + (l15 * 16) + q * 4) = z;
        *(u32x4*)(selI + 256 + (l15 * 16) + q * 4) = z;
        *(f32x4*)(outV + (l15 * 16) + q * 4) = ninf;
        *(u32x4*)(outI + (l15 * 16) + q * 4) = z;
      }
      float mx12[2], mn12[2];
#pragma unroll
      for (int pp = 0; pp < 2; ++pp) {
        const float* sp = p.pq + (size_t)(tok0 + l15) * 2048 + h * 256 + pp * 128 + q * 32;
        f32x4 sw[8];
#pragma unroll
        for (int i = 0; i < 8; ++i) sw[i] = *(const f32x4*)(sp + i * 4);
        float v[32];
        float mx = -INFINITY, mn = INFINITY;
#pragma unroll
        for (int i = 0; i < 8; ++i)
#pragma unroll
          for (int k = 0; k < 4; ++k) {
            v[i * 4 + k] = sw[i][k];
            mx = fmaxf(mx, sw[i][k]);
            mn = fminf(mn, sw[i][k]);
          }
        mx = quad_max_f(mx);
        mn = quad_min_f(mn);
        float tau = bisect16<32>(v, mn - 1.f, mx);
        int cl = 0;
#pragma unroll
        for (int k = 0; k < 32; ++k) cl += (v[k] > tau) ? 1 : 0;
        int c0 = __shfl(cl, l15), c1 = __shfl(cl, l15 + 16), c2 = __shfl(cl, l15 + 32);
        int slot = (q > 0 ? c0 : 0) + (q > 1 ? c1 : 0) + (q > 2 ? c2 : 0);
        float smin = INFINITY;
#pragma unroll
        for (int k = 0; k < 32; ++k) {
          if (v[k] > tau) {
            int sl = slot < 15 ? slot : 15;
            selV[pp * 256 + l15 * 16 + sl] = v[k];
            selI[pp * 256 + l15 * 16 + sl] = q * 32 + k;
            smin = fminf(smin, v[k]);
            slot++;
          }
        }
        mx12[pp] = mx;
        mn12[pp] = quad_min_f(smin);
      }
      __builtin_amdgcn_fence(__ATOMIC_RELEASE, "wavefront");
      __builtin_amdgcn_wave_barrier();
      float cand[64];
      int ai[4];
      {
        f32x4 a4 = *(const f32x4*)(selV + l15 * 16 + q * 4);
        u32x4 ai4 = *(const u32x4*)(selI + l15 * 16 + q * 4);
#pragma unroll
        for (int ii = 0; ii < 4; ++ii) ai[ii] = (int)ai4[ii];
#pragma unroll
        for (int j4 = 0; j4 < 4; ++j4) {
          f32x4 b4 = *(const f32x4*)(selV + 256 + l15 * 16 + j4 * 4);
#pragma unroll
          for (int ii = 0; ii < 4; ++ii)
#pragma unroll
            for (int jj = 0; jj < 4; ++jj) cand[ii * 16 + j4 * 4 + jj] = a4[ii] + b4[jj];
        }
      }
      const float m2 = mx12[0] + mx12[1];
      float lo2 = mn12[0] + mn12[1] - 1.f;
      if (!(lo2 > -1e30f)) lo2 = -1e30f;
      float tau2 = bisect16<64>(cand, lo2, m2);
      {
        int cl = 0;
#pragma unroll
        for (int k = 0; k < 64; ++k) cl += (cand[k] > tau2) ? 1 : 0;
        int c0 = __shfl(cl, l15), c1 = __shfl(cl, l15 + 16), c2 = __shfl(cl, l15 + 32);
        int slot = (q > 0 ? c0 : 0) + (q > 1 ? c1 : 0) + (q > 2 ? c2 : 0);
#pragma unroll
        for (int k = 0; k < 64; ++k) {
          if (cand[k] > tau2) {
            int sl = slot < 15 ? slot : 15;
            outV[l15 * 16 + sl] = cand[k];
            outI[l15 * 16 + sl] = ai[k >> 4] * 128 + selI[256 + l15 * 16 + (k & 15)];
            slot++;
          }
        }
      }
      __builtin_amdgcn_fence(__ATOMIC_RELEASE, "wavefront");
      __builtin_amdgcn_wave_barrier();
      {
        f32x4 v4 = *(const f32x4*)(outV + l15 * 16 + q * 4);
        u32x4 i4 = *(const u32x4*)(outI + l15 * 16 + q * 4);
        f32x4 e4;
        float ssum = 0.f;
#pragma unroll
        for (int k = 0; k < 4; ++k) {
          e4[k] = expf(v4[k] - m2);
          ssum += e4[k];
        }
        ssum = rows_sum(ssum);
        float inv = 1.f / ssum;
#pragma unroll
        for (int k = 0; k < 4; ++k) e4[k] *= inv;
        size_t o = (size_t)(tok0 + l15) * 128 + h * 16 + q * 4;
        *(u32x4*)(p.pidx + o) = i4;
        *(f32x4*)(p.pgate + o) = e4;
      }
      __builtin_amdgcn_wave_barrier();
    }
  }
}

DI void phase_experts_u(const Params& p, int layer, int ntok) {
  const int lane = get_tid() & 63, wave = get_tid() >> 6;
  const unsigned char* ub = p.u_q + (size_t)layer * 16384 * 1024;
  const float* usc = p.u_sc + layer * 16384;
  const float* vsc = p.v_sc + layer * 16384;
  const int tstride = gridDim.x * 4;
  int tok = blockIdx.x * 4 + wave;
  u32x4 xa = u32x4{0u, 0u, 0u, 0u}, xb = xa;
  int i0 = 0, i1 = 0;
  float g0 = 0.f, g1 = 0.f;
  if (tok < ntok) {
    const bf16_t* hrow = p.mix + (size_t)tok * 1024 + lane * 16;
    xa = *(const u32x4*)hrow;
    xb = *(const u32x4*)(hrow + 8);
    i0 = p.pidx[(size_t)tok * 128 + lane];
    i1 = p.pidx[(size_t)tok * 128 + 64 + lane];
    g0 = p.pgate[(size_t)tok * 128 + lane];
    g1 = p.pgate[(size_t)tok * 128 + 64 + lane];
  }
  for (; tok < ntok; tok += tstride) {
    const int tn = tok + tstride;
    u32x4 nxa = u32x4{0u, 0u, 0u, 0u}, nxb = nxa;
    int ni0 = 0, ni1 = 0;
    float ng0 = 0.f, ng1 = 0.f;
    if (tn < ntok) {
      const bf16_t* nrow = p.mix + (size_t)tn * 1024 + lane * 16;
      nxa = *(const u32x4*)nrow;
      nxb = *(const u32x4*)(nrow + 8);
      ni0 = p.pidx[(size_t)tn * 128 + lane];
      ni1 = p.pidx[(size_t)tn * 128 + 64 + lane];
      ng0 = p.pgate[(size_t)tn * 128 + lane];
      ng1 = p.pgate[(size_t)tn * 128 + 64 + lane];
    }
    float xf[16];
    float xs = 0.f;
#pragma unroll
    for (int k = 0; k < 4; ++k) {
      xf[2 * k] = __uint_as_float(xa[k] << 16);
      xf[2 * k + 1] = __uint_as_float(xa[k] & 0xffff0000u);
      xf[8 + 2 * k] = __uint_as_float(xb[k] << 16);
      xf[8 + 2 * k + 1] = __uint_as_float(xb[k] & 0xffff0000u);
    }
#pragma unroll
    for (int k = 0; k < 16; ++k) xs += xf[k];
    const float XS128 = 128.f * wave_sum(xs);
    constexpr int EU = 16;
    for (int e = 0; e < 128; e += EU) {
      u32x4 uq[EU];
#pragma unroll
      for (int u = 0; u < EU; ++u) {
        int ee = e + u;
        int row = __builtin_amdgcn_readlane(ee < 64 ? i0 : i1, ee & 63);
        uq[u] = *(const u32x4*)(ub + (size_t)row * 1024 + lane * 16);
      }
      const int esel = e + (lane & (EU - 1));
      const int myrow = __shfl(esel < 64 ? i0 : i1, esel & 63);
      const float mygate = __shfl(esel < 64 ? g0 : g1, esel & 63);
      const float mysu = usc[myrow], mysv = vsc[myrow];
      float d[EU];
#pragma unroll
      for (int u = 0; u < EU; ++u) {
        float sacc = 0.f;
#pragma unroll
        for (int k = 0; k < 4; ++k) {
          unsigned w = uq[u][k];
          sacc += xf[4 * k] * (float)(w & 0xffu);
          sacc += xf[4 * k + 1] * (float)((w >> 8) & 0xffu);
          sacc += xf[4 * k + 2] * (float)((w >> 16) & 0xffu);
          sacc += xf[4 * k + 3] * (float)(w >> 24);
        }
        d[u] = wave_sum(sacc);
      }
      float dsel = d[0];
#pragma unroll
      for (int u = 1; u < EU; ++u) dsel = ((lane & (EU - 1)) == u) ? d[u] : dsel;
      const float xd = mysu * (dsel - XS128);
      const float c2l = mygate * 0.5f * xd * (1.f + erff(xd * 0.7071067811865476f)) * mysv;
      if (lane < EU) p.pgate[(size_t)tok * 128 + e + lane] = c2l;
    }
    xa = nxa; xb = nxb; i0 = ni0; i1 = ni1; g0 = ng0; g1 = ng1;
  }
}

DI void phase_experts(const Params& p, int layer, int ntok, int dry) {
  const int lane = get_tid() & 63, wave = get_tid() >> 6;
  const unsigned char* vb = p.v_q + (size_t)layer * 16384 * 1024;
  const int tstride = gridDim.x * 4;
  int tok = blockIdx.x * 4 + wave;
  int i0 = 0, i1 = 0;
  float g0 = 0.f, g1 = 0.f;
  if (tok < ntok) {
    i0 = p.pidx[(size_t)tok * 128 + lane];
    i1 = p.pidx[(size_t)tok * 128 + 64 + lane];
    g0 = p.pgate[(size_t)tok * 128 + lane];
    g1 = p.pgate[(size_t)tok * 128 + 64 + lane];
  }
  for (; tok < ntok; tok += tstride) {
    const int tn = tok + tstride;
    int ni0 = 0, ni1 = 0;
    float ng0 = 0.f, ng1 = 0.f;
    if (tn < ntok) {
      ni0 = p.pidx[(size_t)tn * 128 + lane];
      ni1 = p.pidx[(size_t)tn * 128 + 64 + lane];
      ng0 = p.pgate[(size_t)tn * 128 + lane];
      ng1 = p.pgate[(size_t)tn * 128 + 64 + lane];
    }
    float* xr = tok < NLAT ? p.out + (size_t)tok * 1024 : p.xc + (size_t)(tok - NLAT) * 1024;
    f32x4 xres[4];
#pragma unroll
    for (int j = 0; j < 4; ++j) xres[j] = *(const f32x4*)(xr + lane * 16 + j * 4);
    float acc[16];
#pragma unroll
    for (int k = 0; k < 16; ++k) acc[k] = 0.f;
    float csum = 0.f;
    constexpr int EU = 16;
    for (int e = 0; e < 128; e += EU) {
      u32x4 vq[EU];
      float c2s[EU];
#pragma unroll
      for (int u = 0; u < EU; ++u) {
        int ee = e + u;
        int row = __builtin_amdgcn_readlane(ee < 64 ? i0 : i1, ee & 63);
        c2s[u] = __uint_as_float(__builtin_amdgcn_readlane(__float_as_uint(ee < 64 ? g0 : g1), ee & 63));
        vq[u] = *(const u32x4*)(vb + (size_t)row * 1024 + lane * 16);
      }
#pragma unroll
      for (int u = 0; u < EU; ++u) {
        const float c2 = c2s[u];
        csum += c2;
#pragma unroll
        for (int k = 0; k < 4; ++k) {
          unsigned w = vq[u][k];
          acc[4 * k] += c2 * (float)(w & 0xffu);
          acc[4 * k + 1] += c2 * (float)((w >> 8) & 0xffu);
          acc[4 * k + 2] += c2 * (float)((w >> 16) & 0xffu);
          acc[4 * k + 3] += c2 * (float)(w >> 24);
        }
      }
    }
#pragma unroll
    for (int k = 0; k < 16; ++k) acc[k] -= 128.f * csum;
    i0 = ni0; i1 = ni1; g0 = ng0; g1 = ng1;
    int vec = vec_of_row(tok);
    const float* g2 = modp(p, layer, vec, 5);
    float xn[16];
    float ss = 0.f;
#pragma unroll
    for (int hlf = 0; hlf < 2; ++hlf) {
      int c0 = lane * 16 + hlf * 8;
      float4 a = float4{xres[hlf * 2][0], xres[hlf * 2][1], xres[hlf * 2][2], xres[hlf * 2][3]};
      float4 bq = float4{xres[hlf * 2 + 1][0], xres[hlf * 2 + 1][1], xres[hlf * 2 + 1][2], xres[hlf * 2 + 1][3]};
      float4 ga = *(const float4*)(g2 + c0), gb = *(const float4*)(g2 + c0 + 4);
      float* o = xn + hlf * 8;
      o[0] = a.x + ga.x * acc[hlf * 8 + 0];
      o[1] = a.y + ga.y * acc[hlf * 8 + 1];
      o[2] = a.z + ga.z * acc[hlf * 8 + 2];
      o[3] = a.w + ga.w * acc[hlf * 8 + 3];
      o[4] = bq.x + gb.x * acc[hlf * 8 + 4];
      o[5] = bq.y + gb.y * acc[hlf * 8 + 5];
      o[6] = bq.z + gb.z * acc[hlf * 8 + 6];
      o[7] = bq.w + gb.w * acc[hlf * 8 + 7];
#pragma unroll
      for (int k = 0; k < 8; ++k) ss += o[k] * o[k];
    }
    ss = wave_sum(ss);
    float rstd = rsqrtf(ss * (1.f / 1024.f) + 1e-6f);
    if (dry && ss != -1.f) continue;
    if (layer == 0) {
      const float* nw = p.norm_w + (1 * 2 + 0) * 1024;
      const float* sh = modp(p, 1, vec, 0);
      const float* sc = modp(p, 1, vec, 1);
#pragma unroll
      for (int hlf = 0; hlf < 2; ++hlf) {
        int c0 = lane * 16 + hlf * 8;
        float* o = xn + hlf * 8;
        *(float4*)(xr + c0) = float4{o[0], o[1], o[2], o[3]};
        *(float4*)(xr + c0 + 4) = float4{o[4], o[5], o[6], o[7]};
        float hv[8];
#pragma unroll
        for (int k = 0; k < 8; ++k) hv[k] = o[k] * rstd * nw[c0 + k] * (1.f + sc[c0 + k]) + sh[c0 + k];
        uint4 w;
        w.x = pack2(hv[0], hv[1]);
        w.y = pack2(hv[2], hv[3]);
        w.z = pack2(hv[4], hv[5]);
        w.w = pack2(hv[6], hv[7]);
        *(uint4*)(p.mix + (size_t)tok * 1024 + c0) = w;
      }
    } else {
      const float* fw = p.final_norm_w;
#pragma unroll
      for (int hlf = 0; hlf < 2; ++hlf) {
        int c0 = lane * 16 + hlf * 8;
        float* o = xn + hlf * 8;
        float4 w0 = *(const float4*)(fw + c0), w1 = *(const float4*)(fw + c0 + 4);
        *(float4*)(xr + c0) = float4{o[0] * rstd * w0.x, o[1] * rstd * w0.y, o[2] * rstd * w0.z, o[3] * rstd * w0.w};
        *(float4*)(xr + c0 + 4) = float4{o[4] * rstd * w1.x, o[5] * rstd * w1.y, o[6] * rstd * w1.z, o[7] * rstd * w1.w};
      }
    }
  }
}

DI void run_phase(const Params& p, int ph, char* smem, int rep = 0) {
  switch (ph) {
    case 0: phase_setup(p, smem); break;
    case 1: phase_modulate(p, p.x, p.ctx, NTOK, 0, 0); break;
    case 2: phase_gemm<EPI_IN0>(p, p.mix, p.wt_in0, NTOK, 4096, smem, 0, nullptr, nullptr); break;
    case 3: phase_mixer0(p, smem, rep); break;
    case 4: phase_gemm<EPI_OUT>(p, p.mix, p.wt_out0, NTOK, 1024, smem, 0, p.x, p.ctx, rep); break;
    case 5: phase_modulate(p, p.out, p.xc, NTOK, 0, 1); break;
    case 6: phase_gemm<EPI_PQ>(p, p.mix, p.wt_q, NTOK, 2048, smem, 0, nullptr, nullptr); break;
    case 7: phase_topk(p, smem, 0, NTOK); break;
    case 8: phase_experts_u(p, 0, NTOK); break;
    case 9: phase_experts(p, 0, NTOK, rep); break;
    case 10: phase_gemm<EPI_IN1>(p, p.mix, p.wt_in1, NTOK, 2944, smem, 1, nullptr, nullptr); break;
    case 11: phase_mixer1(p, smem, rep); break;
    case 12: phase_gdn_finalize(p); break;
    case 13: phase_gemm<EPI_OUT>(p, p.mix, p.wt_out1, NLAT, 1024, smem, 1, p.out, p.xc, rep); break;
    case 14: phase_modulate(p, p.out, p.xc, NLAT, 1, 1); break;
    case 15: phase_gemm<EPI_PQ>(p, p.mix, p.wt_q + (size_t)2048 * 1024, NLAT, 2048, smem, 1, nullptr, nullptr); break;
    case 16: phase_topk(p, smem, 1, NLAT); break;
    case 17: phase_experts_u(p, 1, NLAT); break;
    case 18: phase_experts(p, 1, NLAT, rep); break;
  }
}

#define XB_TMO      128
#define XB_XCNT(j)  (256  + 64 * (j))
#define XB_XSUB(j)  (1280 + 64 * (j))
#define XB_XGEN(j)  (2304 + 64 * (j))
#define XB_TOP      3328
#define XB_TOPGEN   3392
#define XCD_BAR_WORDS 3456
#define XB_SPIN_CAP (1u << 18)
#define LAS __attribute__((address_space(3)))

__device__ __forceinline__ unsigned xb_ld(unsigned* p)              { return __hip_atomic_load(p, __ATOMIC_RELAXED, __HIP_MEMORY_SCOPE_AGENT); }
__device__ __forceinline__ unsigned xb_add(unsigned* p, unsigned v) { return __hip_atomic_fetch_add(p, v, __ATOMIC_RELAXED, __HIP_MEMORY_SCOPE_AGENT); }
__device__ __forceinline__ unsigned xb_xcc_id() { return (unsigned)__builtin_amdgcn_s_getreg((3 << 11) | 20) & 0xFu; }
#define XB_SPIN(cond, bar) do { unsigned _sp = 0; while (cond) { __builtin_amdgcn_s_sleep(1); \
    if ((++_sp & 255u) == 0u) { if (xb_ld(&(bar)[XB_TMO])) break; if (_sp > XB_SPIN_CAP) { atomicAdd(&(bar)[XB_TMO], 1u); break; } } } } while (0)

struct XcdBarrier {
    unsigned* bar; unsigned x;
    volatile LAS unsigned* st;
};

__device__ __forceinline__ XcdBarrier xcd_barrier_post(unsigned* bar, volatile LAS unsigned* st) {
    XcdBarrier b; b.bar = bar; b.x = xb_xcc_id(); b.st = st;
    if (threadIdx.x == 0) (void)xb_add(&bar[XB_XCNT(b.x)], 1u);
    return b;
}
__device__ __forceinline__ void xcd_barrier_complete(unsigned* bar, unsigned x, unsigned& nloc, unsigned& nx) {
    const unsigned G = gridDim.x * gridDim.y * gridDim.z;
    unsigned sum, cnt, mine, sp = 0u;
    for (;;) {
        sum = 0u; cnt = 0u; mine = 0u;
#pragma unroll
        for (unsigned j = 0; j < 16; ++j) { const unsigned c = xb_ld(&bar[XB_XCNT(j)]); sum += c; cnt += (c > 0u) ? 1u : 0u; mine = (j == x) ? c : mine; }
        if (sum == G) break;
        __builtin_amdgcn_s_sleep(1);
        if ((++sp & 255u) == 0u) { if (xb_ld(&bar[XB_TMO])) break; if (sp > XB_SPIN_CAP) { atomicAdd(&bar[XB_TMO], 1u); break; } }
    }
    nloc = mine > 0u ? mine : 1u; nx = cnt > 0u ? cnt : 1u;
}

__device__ __forceinline__ void xcd_barrier(const XcdBarrier& b) {
    asm volatile("s_waitcnt vmcnt(0)" ::: "memory");
    __syncthreads();
    if (threadIdx.x == 0) {
        unsigned* bar = b.bar;
        __builtin_amdgcn_s_waitcnt(0);
        unsigned nloc = b.st[0], nx = b.st[1];
        if (nloc == 0u) { xcd_barrier_complete(bar, b.x, nloc, nx); b.st[0] = nloc; b.st[1] = nx; }
        const unsigned old = xb_add(&bar[XB_XSUB(b.x)], 1u);
        const unsigned gen = old / nloc;
        if (old + 1u == (gen + 1u) * nloc) {
            __builtin_amdgcn_fence(__ATOMIC_RELEASE, "agent");
            asm volatile("s_waitcnt vmcnt(0)" ::: "memory");
            const unsigned og = xb_add(&bar[XB_TOP], 1u);
            const unsigned tg = og / nx;
            if (og + 1u == (tg + 1u) * nx) xb_add(&bar[XB_TOPGEN], 1u);
            else XB_SPIN(xb_ld(&bar[XB_TOPGEN]) == tg, bar);
            __builtin_amdgcn_fence(__ATOMIC_ACQUIRE, "agent");
            xb_add(&bar[XB_XGEN(b.x)], 1u);
            asm volatile("s_waitcnt vmcnt(0)" ::: "memory");
        } else {
            XB_SPIN(xb_ld(&bar[XB_XGEN(b.x)]) == gen, bar);
            __builtin_amdgcn_fence(__ATOMIC_ACQUIRE, "agent");
            asm volatile("s_waitcnt vmcnt(0)" ::: "memory");
        }
    }
    __syncthreads();
}


#if SINGLE_LAUNCH
__global__ void __launch_bounds__(NTHREADS, 2) mega_kernel(Params p, int ph_lo, int ph_hi) {
  __shared__ __attribute__((aligned(16))) char smem[SMEM_BYTES];
  __shared__ uint4 xb_words;
  if (threadIdx.x == 0) xb_words = make_uint4(0u, 0u, 0u, 0u);
  __syncthreads();
  XcdBarrier xb = xcd_barrier_post(p.xbar, (volatile LAS unsigned*)&xb_words);
#ifdef PROBE_A
  unsigned long long* tstamp = (unsigned long long*)(p.counters + 16);
#endif
  for (int ph = ph_lo; ph < ph_hi; ++ph) {
    if (ph > ph_lo) {
      if (ph == ph_lo + 1) cg::this_grid().sync();
      else xcd_barrier(xb);
    }
#ifdef PROBE_A
    if (blockIdx.x == 0 && threadIdx.x == 0) tstamp[ph] = wall_clock64();
#endif
    run_phase(p, ph, smem);
#ifdef REPEAT_MASK
    if ((REPEAT_MASK >> ph) & 1) {
      cg::this_grid().sync();
      run_phase(p, ph, smem, 1);
    }
#endif
  }
#ifdef PROBE_A
  cg::this_grid().sync();
  if (blockIdx.x == 0) {
    if (threadIdx.x == 0) tstamp[NPHASES] = wall_clock64();
    __syncthreads();
    float A = 0.f, B = 0.f;
    for (int ph = 0; ph < NPHASES; ++ph) {
      float d = (float)(tstamp[ph + 1] - tstamp[ph]) * 0.01f;
      if ((PROBE_A >> ph) & 1) A += d;
      if ((PROBE_B >> ph) & 1) B += d;
    }
    for (int i = threadIdx.x; i < 65536; i += NTHREADS) p.out[1024 + i] += B;
    if (threadIdx.x == 0) p.out[0] += A;
  }
#endif
}
#define OCC_KERNEL mega_kernel
#else
template <int PH>
__global__ void __launch_bounds__(NTHREADS, (PH == 10 ? 1 : 2)) phase_kernel(Params p) {
  __shared__ __attribute__((aligned(16))) char smem[SMEM_BYTES];
  run_phase(p, PH, smem);
}
#define OCC_KERNEL phase_kernel<3>
template <int PH>
static void launch_phases(const Params& p, int grid, hipStream_t stream) {
  hipLaunchKernelGGL(phase_kernel<PH>, dim3(grid), dim3(NTHREADS), 0, stream, p);
  if constexpr (PH + 1 < NPHASES) launch_phases<PH + 1>(p, grid, stream);
}
#endif

extern "C" void kernel_launch(void* const* d_in, const int* in_sizes, int n_in, void* d_out, int out_size, void* d_ws,
                              size_t ws_size, hipStream_t stream) {
  static int grid_blocks = 0;
  if (!grid_blocks) {
    int dev = 0, cus = 0, per_cu = 0;
    (void)hipGetDevice(&dev);
    (void)hipDeviceGetAttribute(&cus, hipDeviceAttributeMultiprocessorCount, dev);
    (void)hipOccupancyMaxActiveBlocksPerMultiprocessor(&per_cu, OCC_KERNEL, NTHREADS, 0);
    if (per_cu < 1) per_cu = 1;
    if (per_cu > 2) per_cu = 2;
    grid_blocks = cus * per_cu;
  }
  Params p{};
  const float** fp = (const float**)&p;
  for (int i = 0; i < 25; ++i) fp[i] = (const float*)d_in[i];
  p.out = (float*)d_out;
  char* ws = (char*)d_ws;
  size_t off = 0;
  auto take = [&](size_t bytes) { char* r = ws + off; off += (bytes + 255) & ~(size_t)255; return r; };
  p.proj = (bf16_t*)take((size_t)NTOK * LD0 * 2);
  p.mix = (bf16_t*)take((size_t)NTOK * 1024 * 2);
  p.xc = (float*)take((size_t)NCTX * 1024 * 4);
  p.mod = (float*)take((size_t)2 * 33 * 6144 * 4);
  p.rope = (float*)take(64 * 16 * 2 * 4);
  p.wt_in0 = (bf16_t*)take((size_t)4096 * 1024 * 2);
  p.wt_out0 = (bf16_t*)take((size_t)1024 * 1024 * 2);
  p.wt_in1 = (bf16_t*)take((size_t)2944 * 1024 * 2);
  p.wt_out1 = (bf16_t*)take((size_t)1024 * 1024 * 2);
  p.wt_q = (bf16_t*)take((size_t)2 * 2048 * 1024 * 2);
  p.keys_bf = (bf16_t*)take((size_t)2 * 8 * 2 * 128 * 128 * 2);
  p.u_q = (unsigned char*)take((size_t)2 * 16384 * 1024);
  p.v_q = (unsigned char*)take((size_t)2 * 16384 * 1024);
  p.u_sc = (float*)take((size_t)2 * 16384 * 4);
  p.v_sc = (float*)take((size_t)2 * 16384 * 4);
  p.counters = (unsigned*)take(256);
  p.xbar = (unsigned*)take((size_t)XCD_BAR_WORDS * 4);
  p.pq = (float*)p.proj;
  p.pidx = (int*)take((size_t)NTOK * 128 * 4);
  p.pgate = (float*)take((size_t)NTOK * 128 * 4);
  p.gdn_of = (bf16_t*)((char*)p.proj + (size_t)NTOK * LD1 * 2);
  p.gdn_ob = p.gdn_of + (size_t)NLAT * 512;
  if (off > ws_size) fprintf(stderr, "workspace too small: need %zu have %zu\n", off, ws_size);
  (void)hipMemsetAsync(p.counters, 0, 256 + (size_t)XCD_BAR_WORDS * 4, stream);
#if SINGLE_LAUNCH
  int lo = 0, hi = NPHASES;
  void* args[] = {&p, &lo, &hi};
  hipError_t e = hipLaunchCooperativeKernel((void*)mega_kernel, dim3(grid_blocks), dim3(NTHREADS), args, 0, stream);
  if (e != hipSuccess) fprintf(stderr, "cooperative launch failed: %s (grid %d)\n", hipGetErrorString(e), grid_blocks);
#else
  launch_phases<0>(p, grid_blocks, stream);
#endif
}
```
